# Optimizing an MI355X kernel written in HIP

```python
import jax, jax.numpy as jnp
from jax import lax
import numpy as np

D_MODEL = 1024
BATCH = 8
SEQ = 2048
DEPTH = 1
DEC_BATCH = 128
DEC_SEQ = 8
PAST_LEN = 16384
PAGE_SIZE = 128

N_META = 16
D_RNN = D_MODEL
LRU_BLOCKS = 8
LRU_BLOCK = D_RNN // LRU_BLOCKS
CONV_W = 4
LRU_C = 8.0
HG_HEADS = 8
HG_DK = 128
HG_DV = D_MODEL // HG_HEADS
D_HG_K = HG_HEADS * HG_DK
D_HG_V = HG_HEADS * HG_DV
HG_CHUNK = 32
D_FF = 4 * D_MODEL
EPS = 1e-6
COL_WIDTHS = (D_RNN, D_RNN, D_HG_K, D_HG_K, D_HG_V, D_HG_V, D_MODEL, D_MODEL)
D_IN = D_RNN * 2 + D_HG_K * 2 + D_HG_V * 2 + D_MODEL * 2

kernel_name = 'hybrid_rglru_hgrn2_meta_decode_step'


def rms_norm(x, g):
    xf = x.astype(jnp.float32)
    y = xf * lax.rsqrt(jnp.mean(xf * xf, axis=-1, keepdims=True) + EPS)
    return (y * g.astype(jnp.float32)).astype(x.dtype)


def causal_conv(u, buf, w, b):
    L = u.shape[1]
    up = jnp.concatenate([buf.astype(u.dtype), u], axis=1)
    out = b + w[0] * up[:, 0:L]
    for k in range(1, CONV_W):
        out = out + w[k] * up[:, k:k + L]
    return out, up[:, L:]


def block_diag(u, w, b):
    ub = u.reshape(u.shape[:-1] + (LRU_BLOCKS, LRU_BLOCK))
    return jnp.einsum('blhi,hij->blhj', ub, w.astype(jnp.float32)).reshape(u.shape) + b.astype(jnp.float32)


def rg_lru(u, h0, w_r, b_r, w_i, b_i, lam, reset_first):
    uf = u.astype(jnp.float32)
    r = jax.nn.sigmoid(block_diag(uf, w_r, b_r))
    ig = jax.nn.sigmoid(block_diag(uf, w_i, b_i))
    log_a = -LRU_C * r * jax.nn.softplus(-lam.astype(jnp.float32))
    a = jnp.exp(log_a)
    mult = jnp.sqrt(-jnp.expm1(2.0 * log_a))
    if reset_first:
        mult = mult.at[:, 0].set(1.0)
    bterm = mult * ig * uf

    def combine(c1, c2):
        a1, b1 = c1
        a2, b2 = c2
        return a1 * a2, a2 * b1 + b2

    a_cum, b_cum = lax.associative_scan(combine, (a, bterm), axis=1)
    h = a_cum * h0.astype(jnp.float32)[:, None] + b_cum
    return h, h[:, -1]


def hgrn2_chunk(S, q, k, v, logf):
    C = q.shape[1]
    b = jnp.cumsum(logf, axis=1)
    o_inter = jnp.einsum('bthk,bhkv->bthv', q * jnp.exp(b), S)
    causal = jnp.tril(jnp.ones((C, C), dtype=bool))
    diff = b[:, :, None] - b[:, None, :]
    decay = jnp.where(causal[None, :, :, None, None], jnp.exp(jnp.minimum(diff, 0.0)), 0.0)
    A = jnp.einsum('bthk,btshk,bshk->bhts', q, decay, k)
    o_intra = jnp.einsum('bhts,bshv->bthv', A, v)
    b_last = b[:, -1]
    S_new = jnp.exp(b_last)[..., None] * S + jnp.einsum('bshk,bshv->bhkv', k * jnp.exp(b_last[:, None] - b), v)
    return S_new, o_inter + o_intra


def hgrn2(q, f, i, S0, lb, meta_lead):
    Bn, L, _ = q.shape
    qf = jax.nn.silu(q.astype(jnp.float32)).reshape(Bn, L, HG_HEADS, HG_DK)
    fg = lb + (1.0 - lb) * jax.nn.sigmoid(f.astype(jnp.float32))
    logf = jnp.log(fg).reshape(Bn, L, HG_HEADS, HG_DK)
    k = (1.0 - fg).reshape(Bn, L, HG_HEADS, HG_DK)
    v = i.astype(jnp.float32).reshape(Bn, L, HG_HEADS, HG_DV)
    S0 = S0.astype(jnp.float32)
    if meta_lead:
        S, o_meta = hgrn2_chunk(S0, qf[:, :N_META], k[:, :N_META], v[:, :N_META], logf[:, :N_META])
        rest = L - N_META
        n_chunks = rest // HG_CHUNK

        def to_chunks(t):
            return t[:, N_META:].reshape((Bn, n_chunks, HG_CHUNK) + t.shape[2:]).swapaxes(0, 1)

        def step(S_c, xs):
            return hgrn2_chunk(S_c, *xs)

        S, o_rest = lax.scan(step, S, (to_chunks(qf), to_chunks(k), to_chunks(v), to_chunks(logf)))
        o_rest = o_rest.swapaxes(0, 1).reshape(Bn, rest, HG_HEADS, HG_DV)
        o = jnp.concatenate([o_meta, o_rest], axis=1)
    else:
        S, o = hgrn2_chunk(S0, qf, k, v, logf)
    return o, S


def layer(x, conv_buf, h0, S0, is_prompt, lb, gains, w_in, conv_w, conv_b, rg_w, rg_b, ig_w, ig_b,
          lru_lambda, hg_gnorm, w_branch_a, w_branch_b, w_out, w_up, w_down):
    Bn, L, _ = x.shape
    xn = rms_norm(x, gains[0])
    proj = xn @ w_in
    split_idx = np.cumsum(np.array(COL_WIDTHS))[:-1].tolist()
    u, gate_a, q, f, i, og, m_a, m_b = jnp.split(proj, split_idx, axis=-1)
    uc, conv_new = causal_conv(u, conv_buf, conv_w, conv_b)
    h, h_last = rg_lru(uc, h0, rg_w, rg_b, ig_w, ig_b, lru_lambda, is_prompt)
    y_a = h.astype(x.dtype) * jax.nn.gelu(gate_a)
    o, S_new = hgrn2(q, f, i, S0, lb, is_prompt)
    o = rms_norm(o, hg_gnorm.reshape(HG_HEADS, HG_DV)).reshape(Bn, L, D_HG_V)
    y_b = o.astype(x.dtype) * jax.nn.silu(og)
    mixed = jax.nn.sigmoid(m_a) * (y_a @ w_branch_a) + jax.nn.sigmoid(m_b) * (y_b @ w_branch_b)
    x = x + rms_norm(mixed @ w_out, gains[1])
    hn = rms_norm(x, gains[2])
    ff = jnp.square(jax.nn.relu(hn @ w_up)) @ w_down
    x = x + rms_norm(ff, gains[3])
    return x, conv_new, h_last, S_new


def setup_inputs(seed: int = 0) -> dict:
    key = jax.random.key(seed)
    ks = jax.random.split(key, 24)
    nrm = jax.random.normal
    f32 = jnp.float32
    u = jax.random.uniform(ks[13], (DEPTH, D_RNN), f32, 0.9, 0.999) ** (1.0 / LRU_C)
    return {
        'x_prompt': nrm(ks[0], (BATCH, SEQ, D_MODEL), f32),
        'x_sample': nrm(ks[1], (DEC_BATCH, DEC_SEQ, D_MODEL), f32),
        'state_conv': nrm(ks[2], (DEPTH, DEC_BATCH, CONV_W - 1, D_RNN), f32),
        'state_rglru': nrm(ks[3], (DEPTH, DEC_BATCH, D_RNN), f32),
        'state_hgrn': 0.5 * nrm(ks[4], (DEPTH, DEC_BATCH, HG_HEADS, HG_DK, HG_DV), f32),
        'meta_tokens': nrm(ks[5], (N_META, D_MODEL), f32),
        'norm_gains': 1.0 + 0.05 * nrm(ks[6], (DEPTH, 4, D_MODEL), f32),
        'w_in': nrm(ks[7], (DEPTH, D_MODEL, D_IN), f32) * D_MODEL ** -0.5,
        'conv_w': nrm(ks[8], (DEPTH, CONV_W, D_RNN), f32) * CONV_W ** -0.5,
        'conv_b': 0.02 * nrm(ks[9], (DEPTH, D_RNN), f32),
        'rg_w': nrm(ks[10], (DEPTH, LRU_BLOCKS, LRU_BLOCK, LRU_BLOCK), f32) * LRU_BLOCK ** -0.5,
        'rg_b': 0.02 * nrm(ks[11], (DEPTH, D_RNN), f32),
        'ig_w': nrm(ks[12], (DEPTH, LRU_BLOCKS, LRU_BLOCK, LRU_BLOCK), f32) * LRU_BLOCK ** -0.5,
        'ig_b': 0.02 * nrm(ks[14], (DEPTH, D_RNN), f32),
        'lru_lambda': jnp.log(u) - jnp.log1p(-u),
        'hgrn_lb': 0.5 * nrm(ks[15], (DEPTH + 1, D_HG_K), f32),
        'hgrn_gnorm': 1.0 + 0.05 * nrm(ks[16], (DEPTH, D_HG_V), f32),
        'w_branch_a': nrm(ks[17], (DEPTH, D_RNN, D_MODEL), f32) * D_RNN ** -0.5,
        'w_branch_b': nrm(ks[18], (DEPTH, D_HG_V, D_MODEL), f32) * D_HG_V ** -0.5,
        'w_out': nrm(ks[19], (DEPTH, D_MODEL, D_MODEL), f32) * D_MODEL ** -0.5,
        'w_up': nrm(ks[20], (DEPTH, D_MODEL, D_FF), f32) * D_MODEL ** -0.5,
        'w_down': nrm(ks[21], (DEPTH, D_FF, D_MODEL), f32) * D_FF ** -0.5,
    }


def reference(x_prompt, x_sample, state_conv, state_rglru, state_hgrn, meta_tokens, norm_gains, w_in,
              conv_w, conv_b, rg_w, rg_b, ig_w, ig_b, lru_lambda, hgrn_lb, hgrn_gnorm,
              w_branch_a, w_branch_b, w_out, w_up, w_down):
    bp = x_prompt.shape[0]
    meta = jnp.broadcast_to(meta_tokens.astype(x_prompt.dtype)[None], (bp, N_META, D_MODEL))
    xp = jnp.concatenate([meta, x_prompt], axis=1)
    xs = x_sample
    lb_all = jnp.cumsum(jax.nn.softmax(hgrn_lb.astype(jnp.float32), axis=0), axis=0)
    conv_p, h_p, S_p, conv_s, h_s, S_s = [], [], [], [], [], []
    for l in range(DEPTH):
        params = (norm_gains[l], w_in[l], conv_w[l], conv_b[l], rg_w[l], rg_b[l], ig_w[l], ig_b[l],
                  lru_lambda[l], hgrn_gnorm[l], w_branch_a[l], w_branch_b[l], w_out[l], w_up[l], w_down[l])
        zc = jnp.zeros((bp, CONV_W - 1, D_RNN), xp.dtype)
        zh = jnp.zeros((bp, D_RNN), jnp.float32)
        zS = jnp.zeros((bp, HG_HEADS, HG_DK, HG_DV), jnp.float32)
        xp, c1, h1, s1 = layer(xp, zc, zh, zS, True, lb_all[l], *params)
        xs, c2, h2, s2 = layer(xs, state_conv[l], state_rglru[l], state_hgrn[l], False, lb_all[l], *params)
        conv_p.append(c1); h_p.append(h1); S_p.append(s1)
        conv_s.append(c2); h_s.append(h2); S_s.append(s2)
    y_prompt = xp[:, N_META:]
    y_sample = xs
    return (y_prompt, y_sample, jnp.stack(conv_p), jnp.stack(h_p), jnp.stack(S_p),
            jnp.stack(conv_s), jnp.stack(h_s), jnp.stack(S_s))
```

```cpp
#include <hip/hip_runtime.h>
#include <hip/hip_cooperative_groups.h>
#include <cstdio>
#include <cstdint>
namespace cg = cooperative_groups;

constexpr int D = 1024, NB = 8, SEQ = 2048, NMETA = 16, DBATCH = 128, DSEQ = 8, DIN = 8192, DFF = 4096;
constexpr int ROW_SAMPLE = NB * SEQ;
constexpr int M_MAIN = ROW_SAMPLE + DBATCH * DSEQ;
constexpr int ROW_META = M_MAIN;
constexpr int M_REAL = M_MAIN + NMETA;
constexpr int M_PAD = 17664;
constexpr float EPS = 1e-6f;

constexpr size_t MiB = 1u << 20;
constexpr size_t WS_CTL = 0, CTL_ZERO_BYTES = 1 * MiB;
constexpr size_t WS_WIN = 1 * MiB, WS_WUP = 17 * MiB, WS_WDN = 25 * MiB, WS_WA = 33 * MiB, WS_WB = 35 * MiB, WS_WOUT = 37 * MiB, WS_WRG = 39 * MiB;
constexpr size_t AGG_BYTES = (size_t)NB * 33 * 1024 * 4;
constexpr size_t WS_AGGA = 39 * MiB + 512 * 1024, WS_AGGB = WS_AGGA + AGG_BYTES;
constexpr size_t GRP_BYTES = (size_t)M_PAD * 1024 * 2;
constexpr size_t WS_GRP0 = 42 * MiB;
constexpr size_t WS_END = WS_GRP0 + 6 * GRP_BYTES;
static_assert(WS_AGGB + AGG_BYTES <= WS_GRP0 && WS_END <= 256 * MiB, "d_ws map");
constexpr int G_U = 0, G_GA = 1, G_Q = 2, G_LF = 3, G_V = 4, G_OG = 5;
constexpr size_t OFF_Y = 0, OFF_CONVP = 17825792, OFF_HP = 17850368, OFF_SP = 17858560, OFF_CONVS = 18907136, OFF_HS = 19300352, OFF_SS = 19431424, OUT_FLOATS = 36208640;
constexpr size_t GATE_BYTES = (size_t)M_MAIN * 1024 * 2;
static_assert(2 * GATE_BYTES == OFF_CONVP * 4, "gates fill the y region exactly");
#define N_LAUNCH_MODE 1
namespace pg8 {
#define PG8_LAS __attribute__((address_space(3)))
typedef unsigned short bf16_t;
typedef short bf16x8 __attribute__((ext_vector_type(8)));
typedef float f32x4 __attribute__((ext_vector_type(4)));
typedef unsigned u32x4 __attribute__((ext_vector_type(4)));
constexpr int BM = 256, BK = 64, HALF = 128, HTB = HALF * BK * 2  , STAGE_BYTES = 8 * HTB, NXCD = 8, WGM = 8;

__host__ __device__ __forceinline__ int lds_byte(int r, int c) { const int st = (r >> 4) * 2 + (c >> 5), rr = r & 15, cc = c & 31, ob = rr * 64 + cc * 2; return st * 1024 + (ob ^ (((ob >> 9) & 1) << 5)); }
__host__ __device__ __forceinline__ void stage_rc(int b, int& R, int& C) { const int st = b / 1024, sb = b % 1024, swz = sb ^ (((sb >> 9) & 1) << 5); R = (st >> 1) * 16 + swz / 64; C = (st & 1) * 32 + (swz % 64) / 2; }
__host__ __device__ __forceinline__ int perm32(int rho) { const int n = rho >> 4, i = rho & 15; return 8 * (i >> 2) + 4 * n + (i & 3); }

struct Unit { int pm, pn; };
struct Gemm { const bf16_t* A; const bf16_t* Bt; int M, N, K; };

struct StaticOrder {
    int nM, nN, nwg, G, c;
    __host__ __device__ void init(int M, int N, int G_, int c_) { nM = M / BM; nN = N / BM; nwg = nM * nN; G = G_; c = c_; }
    __host__ __device__ bool next(int i, Unit& u) const {
        const long L = (long)i * G + c; if (L >= nwg) return false;
        int wgid = (int)L; { const int q = nwg / NXCD, r = nwg % NXCD, xcd = wgid % NXCD, off = wgid / NXCD; wgid = (xcd < r ? xcd * (q + 1) : r * (q + 1) + (xcd - r) * q) + off; }
        const int nig = WGM * nN, gid = wgid / nig, fm = gid * WGM, gsz = (nM - fm) < WGM ? (nM - fm) : WGM;
        u.pm = fm + ((wgid % nig) % gsz); u.pn = (wgid % nig) / gsz; return true;
    }
    __device__ __forceinline__ void a_ready(const Unit&) const {}
    __device__ __forceinline__ void done(const Unit&) const {}
};

typedef __bf16 bf16x2n __attribute__((ext_vector_type(2)));
typedef float f32x2n __attribute__((ext_vector_type(2)));
__device__ __forceinline__ unsigned cvt_pk_bf16(float lo, float hi) { const f32x2n v = {lo, hi}; const bf16x2n r = __builtin_convertvector(v, bf16x2n); return __builtin_bit_cast(unsigned, r); }
typedef float f32x2 __attribute__((ext_vector_type(2)));

__device__ __forceinline__ float fsig(float x) { return __builtin_amdgcn_rcpf(1.0f + __expf(-x)); }
__device__ __forceinline__ u32x4 pack8(const f32x4 a, const f32x4 b) { u32x4 w; w.x = cvt_pk_bf16(a[0], a[1]); w.y = cvt_pk_bf16(a[2], a[3]); w.z = cvt_pk_bf16(b[0], b[1]); w.w = cvt_pk_bf16(b[2], b[3]); return w; }
__device__ __forceinline__ float bf_lo(unsigned w) { return __uint_as_float(w << 16); }
__device__ __forceinline__ float bf_hi(unsigned w) { return __uint_as_float(w & 0xffff0000u); }

struct EpiProj {
    static constexpr bool PERM = true, AFTER_DRAIN = false;
    unsigned char* ws; unsigned char* outb; const float* hlb;
    __device__ __forceinline__ void operator()(const f32x4 (&acc)[2][2][4][2], const Unit& u, int wr, int wc, int fr, int fq) const {
        const int grp = u.pn >> 2;
        const int cbase = (u.pn & 3) * 256 + wc * 32 + 8 * fq;
        const int row0 = u.pm * BM + wr * 64 + fr;
        bf16_t* base; int rlim;
        if (grp < 6) { base = (bf16_t*)(ws + WS_GRP0 + (size_t)grp * GRP_BYTES); rlim = M_REAL; } else { base = (bf16_t*)(outb + (size_t)(grp - 6) * GATE_BYTES); rlim = M_MAIN; }
        const int mode = (grp == 0 || grp == 4) ? 0 : (grp == 1) ? 1 : (grp == 2 || grp == 5) ? 2 : (grp == 3) ? 3 : 4;
        float lbv[2][8];
#pragma unroll
        for (int bj = 0; bj < 2; ++bj)
#pragma unroll
            for (int e = 0; e < 8; ++e) lbv[bj][e] = 0.f;
        if (mode == 3) {
#pragma unroll
            for (int bj = 0; bj < 2; ++bj)
#pragma unroll
                for (int e = 0; e < 8; ++e) { const int c = cbase + bj * HALF + e; lbv[bj][e] = __builtin_amdgcn_rcpf(1.0f + __expf(hlb[1024 + c] - hlb[c])); }
        }
#pragma unroll
        for (int ai = 0; ai < 2; ++ai)
#pragma unroll
            for (int m = 0; m < 4; ++m) {
                const int r = row0 + ai * HALF + m * 16;
                if (r < rlim) {
                    bf16_t* rowp = base + (size_t)r * 1024 + cbase;
#pragma unroll
                    for (int bj = 0; bj < 2; ++bj) {
                        f32x4 v0 = acc[ai][bj][m][0], v1 = acc[ai][bj][m][1];
                        if (mode == 1) {
#pragma unroll
                            for (int e = 0; e < 4; ++e) { float x = v0[e]; v0[e] = x * fsig(x * (1.5957691216f + 0.0713548163f * x * x)); x = v1[e]; v1[e] = x * fsig(x * (1.5957691216f + 0.0713548163f * x * x)); }
                        } else if (mode == 2) {
#pragma unroll
                            for (int e = 0; e < 4; ++e) { v0[e] = v0[e] * fsig(v0[e]); v1[e] = v1[e] * fsig(v1[e]); }
                        } else if (mode == 3) {
#pragma unroll
                            for (int e = 0; e < 4; ++e) { const float l0 = lbv[bj][e], l1 = lbv[bj][4 + e]; v0[e] = __logf(l0 + (1.0f - l0) * fsig(v0[e])); v1[e] = __logf(l1 + (1.0f - l1) * fsig(v1[e])); }
                        } else if (mode == 4) {
#pragma unroll
                            for (int e = 0; e < 4; ++e) { v0[e] = fsig(v0[e]); v1[e] = fsig(v1[e]); }
                        }
                        *(u32x4*)(rowp + bj * HALF) = pack8(v0, v1);
                    }
                }
            }
    }
};

template <int WHICH> struct EpiGate {
    static constexpr bool PERM = true, AFTER_DRAIN = false;
    const bf16_t* gate; const bf16_t* prev; bf16_t* out;
    __device__ __forceinline__ void operator()(const f32x4 (&acc)[2][2][4][2], const Unit& u, int wr, int wc, int fr, int fq) const {
        const int cbase = u.pn * BM + wc * 32 + 8 * fq;
        const int row0 = u.pm * BM + wr * 64 + fr;
#pragma unroll
        for (int ai = 0; ai < 2; ++ai)
#pragma unroll
            for (int m = 0; m < 4; ++m) {
                const size_t off = (size_t)(row0 + ai * HALF + m * 16) * 1024 + cbase;
#pragma unroll
                for (int bj = 0; bj < 2; ++bj) {
                    const u32x4 g = *(const u32x4*)(gate + off + bj * HALF);
                    f32x4 v0 = acc[ai][bj][m][0], v1 = acc[ai][bj][m][1];
                    v0[0] *= bf_lo(g.x); v0[1] *= bf_hi(g.x); v0[2] *= bf_lo(g.y); v0[3] *= bf_hi(g.y);
                    v1[0] *= bf_lo(g.z); v1[1] *= bf_hi(g.z); v1[2] *= bf_lo(g.w); v1[3] *= bf_hi(g.w);
                    if (WHICH == 1) {
                        const u32x4 q = *(const u32x4*)(prev + off + bj * HALF);
                        v0[0] += bf_lo(q.x); v0[1] += bf_hi(q.x); v0[2] += bf_lo(q.y); v0[3] += bf_hi(q.y);
                        v1[0] += bf_lo(q.z); v1[1] += bf_hi(q.z); v1[2] += bf_lo(q.w); v1[3] += bf_hi(q.w);
                    }
                    *(u32x4*)(out + off + bj * HALF) = pack8(v0, v1);
                }
            }
    }
};

struct EpiF32 {
    static constexpr bool PERM = true, AFTER_DRAIN = false;
    float* out;
    __device__ __forceinline__ void operator()(const f32x4 (&acc)[2][2][4][2], const Unit& u, int wr, int wc, int fr, int fq) const {
        const int cbase = u.pn * BM + wc * 32 + 8 * fq;
        const int row0 = u.pm * BM + wr * 64 + fr;
#pragma unroll
        for (int ai = 0; ai < 2; ++ai)
#pragma unroll
            for (int m = 0; m < 4; ++m) {
                float* rowp = out + (size_t)(row0 + ai * HALF + m * 16) * 1024 + cbase;
#pragma unroll
                for (int bj = 0; bj < 2; ++bj) { *(f32x4*)(rowp + bj * HALF) = acc[ai][bj][m][0]; *(f32x4*)(rowp + bj * HALF + 4) = acc[ai][bj][m][1]; }
            }
    }
};

struct EpiRelu2 {
    static constexpr bool PERM = true, AFTER_DRAIN = false;
    bf16_t* out;
    __device__ __forceinline__ void operator()(const f32x4 (&acc)[2][2][4][2], const Unit& u, int wr, int wc, int fr, int fq) const {
        const int cbase = u.pn * BM + wc * 32 + 8 * fq;
        const int row0 = u.pm * BM + wr * 64 + fr;
#pragma unroll
        for (int ai = 0; ai < 2; ++ai)
#pragma unroll
            for (int m = 0; m < 4; ++m) {
                bf16_t* rowp = out + (size_t)(row0 + ai * HALF + m * 16) * 4096 + cbase;
#pragma unroll
                for (int bj = 0; bj < 2; ++bj) {
                    f32x4 v0 = acc[ai][bj][m][0], v1 = acc[ai][bj][m][1];
#pragma unroll
                    for (int e = 0; e < 4; ++e) { const float a = fmaxf(v0[e], 0.f), b = fmaxf(v1[e], 0.f); v0[e] = a * a; v1[e] = b * b; }
                    *(u32x4*)(rowp + bj * HALF) = pack8(v0, v1);
                }
            }
    }
};

template <class Epi, class Sched, bool ALIGN_EPI = false, bool SP2 = false>
__device__ __forceinline__ void gemm_phase(PG8_LAS unsigned char* lds, const Gemm g, const Sched& S, const Epi& E) {
    const int tid = threadIdx.x, wid = __builtin_amdgcn_readfirstlane(tid >> 6), lane = tid & 63, wr = wid >> 2, wc = wid & 3, fr = lane & 15, fq = lane >> 4;
    const int K = g.K, nt = K / BK;
    unsigned voffA[2], voffB[2];
#pragma unroll
    for (int i = 0; i < 2; ++i) { int R, C; stage_rc(tid * 16 + i * 8192, R, C); const int Rb = Epi::PERM ? ((R & ~31) + perm32(R & 31)) : R;
        voffA[i] = (unsigned)(R * K + C) * 2u; voffB[i] = (unsigned)(Rb * K + C) * 2u; }
    const size_t kstep = (size_t)(BK * 2);
    const size_t hstep = (size_t)HALF * K * 2;
    const size_t tstep = 2 * hstep;
    const unsigned ldsw = (unsigned)wid * 1024u;
    const int aoff = lds_byte(wr * 64 + fr, fq * 8), boff = lds_byte(wc * 32 + fr, fq * 8);
#define PG8_SA(b, h) (((b) * 2 + (h)) * HTB)
#define PG8_SB(b, h) ((4 + (b) * 2 + (h)) * HTB)
#define PG8_STAGE(bufoff, gbase, voff) do { _Pragma("unroll") for (int _i = 0; _i < 2; ++_i) \
        __builtin_amdgcn_global_load_lds((const unsigned*)((const char*)(gbase) + (voff)[_i]), (PG8_LAS unsigned*)(lds + (bufoff) + ldsw + _i * 8192), 16, 0, 0); } while (0)
#define PG8_LDA(dst, b, h) do { _Pragma("unroll") for (int m = 0; m < 4; ++m) _Pragma("unroll") for (int k = 0; k < 2; ++k) dst[m][k] = *(const PG8_LAS bf16x8*)(lds + PG8_SA(b, h) + aoff + m * 2048 + k * 1024); } while (0)
#define PG8_LDB(dst, b, h) do { _Pragma("unroll") for (int n = 0; n < 2; ++n) _Pragma("unroll") for (int k = 0; k < 2; ++k) dst[n][k] = *(const PG8_LAS bf16x8*)(lds + PG8_SB(b, h) + boff + n * 2048 + k * 1024); } while (0)
#define PG8_MMA(ai, bj, At, Bt) do { __builtin_amdgcn_s_setprio(1); _Pragma("unroll") for (int m = 0; m < 4; ++m) _Pragma("unroll") for (int n = 0; n < 2; ++n) _Pragma("unroll") for (int k = 0; k < 2; ++k) \
        acc[ai][bj][m][n] = __builtin_amdgcn_mfma_f32_16x16x32_bf16(Bt[n][k], At[m][k], acc[ai][bj][m][n], 0, 0, 0); __builtin_amdgcn_s_setprio(0); } while (0)
#define PG8_WAIT_V(n) asm volatile("s_waitcnt vmcnt(" #n ")" ::: "memory")
#define PG8_WAIT_L(n) asm volatile("s_waitcnt lgkmcnt(" #n ")" ::: "memory")
#define PG8_BAR __builtin_amdgcn_s_barrier()
#define PG8_SCHED __builtin_amdgcn_sched_barrier(0)
    Unit cur, nxt; int ui = 0;
    if (!S.next(0, cur)) return;
    f32x4 acc[2][2][4][2];
#pragma unroll
    for (int a = 0; a < 2; ++a)
#pragma unroll
        for (int b = 0; b < 2; ++b)
#pragma unroll
            for (int m = 0; m < 4; ++m)
#pragma unroll
                for (int n = 0; n < 2; ++n) acc[a][b][m][n] = (f32x4){0.f, 0.f, 0.f, 0.f};
    bf16x8 At[4][2], B0[2][2], B1[2][2];
    const char* cA = (const char*)g.A + (size_t)cur.pm * tstep; const char* cB = (const char*)g.Bt + (size_t)cur.pn * tstep;
    S.a_ready(cur);
    if constexpr (SP2) {
        PG8_STAGE(PG8_SB(0, 0), cB, voffB); PG8_STAGE(PG8_SB(0, 1), cB + hstep, voffB); PG8_STAGE(PG8_SA(0, 0), cA, voffA); PG8_STAGE(PG8_SA(0, 1), cA + hstep, voffA);
        if (wr == 1) PG8_BAR;
        PG8_WAIT_V(2); PG8_BAR;
        PG8_STAGE(PG8_SB(1, 0), cB + kstep, voffB); PG8_STAGE(PG8_SA(1, 0), cA + kstep, voffA); PG8_STAGE(PG8_SB(1, 1), cB + hstep + kstep, voffB);
        PG8_WAIT_V(6); PG8_BAR;
    } else {
        PG8_STAGE(PG8_SB(0, 0), cB, voffB); PG8_STAGE(PG8_SA(0, 0), cA, voffA); PG8_STAGE(PG8_SB(0, 1), cB + hstep, voffB); PG8_STAGE(PG8_SA(0, 1), cA + hstep, voffA);
        if (wr == 1) PG8_BAR;
        PG8_WAIT_V(4); PG8_BAR;
        PG8_STAGE(PG8_SB(1, 0), cB + kstep, voffB); PG8_STAGE(PG8_SA(1, 0), cA + kstep, voffA); PG8_STAGE(PG8_SB(1, 1), cB + hstep + kstep, voffB);
        PG8_WAIT_V(6); PG8_BAR;
    }
    for (;;) {
        const bool has_next = S.next(ui + 1, nxt);
        const char* nA = has_next ? (const char*)g.A + (size_t)nxt.pm * tstep : cA; const char* nB = has_next ? (const char*)g.Bt + (size_t)nxt.pn * tstep : cB;
        for (int t = 0; t < nt; t += 2) {
            const bool last = (t == nt - 2);
            const char* a1 = cA + (size_t)(t + 1) * kstep;
            const char* a2 = last ? nA : cA + (size_t)(t + 2) * kstep; const char* b2 = last ? nB : cB + (size_t)(t + 2) * kstep;
            const char* a3 = a2 + kstep; const char* b3 = b2 + kstep;
            if (last && has_next) S.a_ready(nxt);
            if constexpr (SP2) {
            PG8_LDB(B0, 0, 0); PG8_LDB(B1, 0, 1); PG8_SCHED; PG8_LDA(At, 0, 0); PG8_STAGE(PG8_SA(1, 1), a1 + hstep, voffA);
            PG8_WAIT_V(8); PG8_WAIT_L(0); PG8_BAR; PG8_MMA(0, 0, At, B0); PG8_MMA(0, 1, At, B1); PG8_BAR; PG8_SCHED;
            PG8_LDA(At, 0, 1); PG8_STAGE(PG8_SB(0, 0), b2, voffB); PG8_STAGE(PG8_SB(0, 1), b2 + hstep, voffB); PG8_STAGE(PG8_SA(0, 0), a2, voffA);
            PG8_WAIT_V(8); PG8_WAIT_L(0); PG8_BAR; PG8_MMA(1, 0, At, B0); PG8_MMA(1, 1, At, B1); PG8_BAR; PG8_SCHED;
            PG8_LDB(B0, 1, 0); PG8_LDB(B1, 1, 1); PG8_SCHED; PG8_LDA(At, 1, 0); PG8_STAGE(PG8_SA(0, 1), a2 + hstep, voffA);
            PG8_WAIT_V(8); PG8_WAIT_L(0); PG8_BAR; PG8_MMA(0, 0, At, B0); PG8_MMA(0, 1, At, B1); PG8_BAR; PG8_SCHED;
            PG8_LDA(At, 1, 1); PG8_STAGE(PG8_SB(1, 0), b3, voffB); PG8_STAGE(PG8_SB(1, 1), b3 + hstep, voffB); PG8_STAGE(PG8_SA(1, 0), a3, voffA);
            PG8_WAIT_V(8); PG8_WAIT_L(0); PG8_BAR; PG8_MMA(1, 0, At, B0); PG8_MMA(1, 1, At, B1); PG8_BAR; PG8_SCHED;
            } else {
            PG8_LDB(B0, 0, 0); PG8_SCHED; PG8_LDA(At, 0, 0); PG8_STAGE(PG8_SA(1, 1), a1 + hstep, voffA);
            PG8_WAIT_L(8); PG8_BAR; PG8_WAIT_L(0); PG8_MMA(0, 0, At, B0); PG8_BAR; PG8_SCHED;
            PG8_LDB(B1, 0, 1); PG8_STAGE(PG8_SB(0, 0), b2, voffB);
            PG8_BAR; PG8_WAIT_L(0); PG8_MMA(0, 1, At, B1); PG8_BAR;
            PG8_LDA(At, 0, 1); PG8_STAGE(PG8_SA(0, 0), a2, voffA);
            PG8_BAR; PG8_WAIT_L(0); PG8_MMA(1, 0, At, B0); PG8_BAR; PG8_SCHED;
            PG8_STAGE(PG8_SB(0, 1), b2 + hstep, voffB);
            PG8_WAIT_V(6); PG8_BAR; PG8_MMA(1, 1, At, B1); PG8_BAR;
            PG8_LDB(B0, 1, 0); PG8_SCHED; PG8_LDA(At, 1, 0); PG8_STAGE(PG8_SA(0, 1), a2 + hstep, voffA);
            PG8_WAIT_L(8); PG8_BAR; PG8_WAIT_L(0); PG8_MMA(0, 0, At, B0); PG8_BAR; PG8_SCHED;
            PG8_LDB(B1, 1, 1); PG8_STAGE(PG8_SB(1, 0), b3, voffB);
            PG8_BAR; PG8_WAIT_L(0); PG8_MMA(0, 1, At, B1); PG8_BAR;
            PG8_LDA(At, 1, 1); PG8_STAGE(PG8_SA(1, 0), a3, voffA);
            PG8_BAR; PG8_WAIT_L(0); PG8_MMA(1, 0, At, B0); PG8_BAR; PG8_SCHED;
            PG8_STAGE(PG8_SB(1, 1), b3 + hstep, voffB);
            PG8_WAIT_V(6); PG8_BAR; PG8_MMA(1, 1, At, B1); PG8_BAR;
            }
        }
        if constexpr (ALIGN_EPI) { if (wr == 0) PG8_BAR; }
        if constexpr (!Epi::AFTER_DRAIN) { E(acc, cur, wr, wc, fr, fq); S.done(cur); }
        if (!has_next) break;
#pragma unroll
        for (int a = 0; a < 2; ++a)
#pragma unroll
            for (int b = 0; b < 2; ++b)
#pragma unroll
                for (int m = 0; m < 4; ++m)
#pragma unroll
                    for (int n = 0; n < 2; ++n) acc[a][b][m][n] = (f32x4){0.f, 0.f, 0.f, 0.f};
        cur = nxt; cA = nA; cB = nB; ++ui;
        if constexpr (ALIGN_EPI) { if (wr == 1) PG8_BAR; }
    }
    PG8_WAIT_V(0);
    if constexpr (!ALIGN_EPI) { if (wr == 0) PG8_BAR; }
    PG8_BAR;
    if constexpr (Epi::AFTER_DRAIN) { E.fused(acc, cur, wr, wc, fr, fq, lds, wid, lane); S.done(cur); }
#undef PG8_SA
#undef PG8_SB
#undef PG8_STAGE
#undef PG8_LDA
#undef PG8_LDB
#undef PG8_MMA
#undef PG8_WAIT_V
#undef PG8_WAIT_L
#undef PG8_BAR
#undef PG8_SCHED
}
}

#define LAS __attribute__((address_space(3)))
typedef unsigned short bf16_t;
typedef short bf16x8 __attribute__((ext_vector_type(8)));
typedef float f32x4 __attribute__((ext_vector_type(4)));
typedef unsigned u32x4 __attribute__((ext_vector_type(4)));
typedef unsigned u32x2 __attribute__((ext_vector_type(2)));
constexpr int NWAVES = 8, NTHREADS = 512;
constexpr int LDS_BYTES = 147456;
constexpr int NPHASES = 12;

struct Params {
    const float *x_prompt, *x_sample, *state_conv, *state_rglru, *state_hgrn, *meta, *gains, *w_in, *conv_w, *conv_b, *rg_w, *rg_b, *ig_w, *ig_b, *lam, *hgrn_lb, *gnorm, *w_a, *w_b, *w_out, *w_up, *w_down;
    float* out; unsigned char* ws;
    int ph_lo, ph_hi, use_bar, pad;
};

using pg8::cvt_pk_bf16;
__device__ __forceinline__ float bflo(unsigned w) { return __uint_as_float(w << 16); }
__device__ __forceinline__ float bfhi(unsigned w) { return __uint_as_float(w & 0xffff0000u); }
__device__ __forceinline__ float bf2f(bf16_t h) { return __uint_as_float((unsigned)h << 16); }
__device__ __forceinline__ bf16_t f2bf(float f) { return (bf16_t)(cvt_pk_bf16(f, 0.f) & 0xffffu); }
__device__ __forceinline__ float fsig(float x) { return __builtin_amdgcn_rcpf(1.0f + __expf(-x)); }
__device__ __forceinline__ float wave_sum(float v) {
#pragma unroll
    for (int o = 1; o < 64; o <<= 1) v += __shfl_xor(v, o);
    return v;
}
__device__ __forceinline__ f32x4 mfma16(bf16x8 first, bf16x8 second, f32x4 c) { return __builtin_amdgcn_mfma_f32_16x16x32_bf16(first, second, c, 0, 0, 0); }

__device__ __forceinline__ void p0_transpose_item(const float* W, int K, int N, bf16_t* WT, int row_off, LAS float* scr, int item, int lane) {
    const int nblk = N / 32, kb = item / nblk, nb = item % nblk, k0 = 64 * kb, n0 = 32 * nb;
#pragma unroll 8
    for (int i = 0; i < 32; ++i) { const int kk = 2 * i + (lane >> 5); scr[kk * 33 + (lane & 31)] = W[(size_t)(k0 + kk) * N + n0 + (lane & 31)]; }
    asm volatile("s_waitcnt lgkmcnt(0)" ::: "memory");
    const int c = lane & 7;
#pragma unroll
    for (int j = 0; j < 4; ++j) { const int n = (lane >> 3) + 8 * j; const LAS float* s = scr + (8 * c) * 33 + n;
        u32x4 o; o.x = cvt_pk_bf16(s[0 * 33], s[1 * 33]); o.y = cvt_pk_bf16(s[2 * 33], s[3 * 33]); o.z = cvt_pk_bf16(s[4 * 33], s[5 * 33]); o.w = cvt_pk_bf16(s[6 * 33], s[7 * 33]);
        *(u32x4*)(WT + (size_t)(row_off + n0 + n) * K + k0 + 8 * c) = o; }
    asm volatile("s_waitcnt lgkmcnt(0)" ::: "memory");
}
__device__ __forceinline__ void rms_row_to_bf16(const float* xrow, const float* g, bf16_t* orow, int lane) {
    const f32x4* xr = (const f32x4*)xrow + lane; const f32x4* gr = (const f32x4*)g + lane;
    f32x4 v[4]; float s = 0.f;
#pragma unroll
    for (int j = 0; j < 4; ++j) { v[j] = xr[64 * j]; s += (v[j].x * v[j].x + v[j].y * v[j].y) + (v[j].z * v[j].z + v[j].w * v[j].w); }
    const float rstd = 1.0f / sqrtf(wave_sum(s) * (1.f / D) + EPS);
    u32x2* o8 = (u32x2*)orow + lane;
#pragma unroll
    for (int j = 0; j < 4; ++j) { const f32x4 gg = gr[64 * j]; u32x2 w; w.x = cvt_pk_bf16(v[j].x * rstd * gg.x, v[j].y * rstd * gg.y); w.y = cvt_pk_bf16(v[j].z * rstd * gg.z, v[j].w * rstd * gg.w); o8[64 * j] = w; }
}
__device__ __forceinline__ void p0_prologue(const Params& p, LAS unsigned char* lds) {
    const int tid = threadIdx.x, lane = tid & 63, wave = __builtin_amdgcn_readfirstlane(tid >> 6);
    LAS float* scr = (LAS float*)(lds + wave * 16384);
    const int gw = blockIdx.x * NWAVES + wave, NGW = gridDim.x * NWAVES;
    constexpr int I_IN = (D / 64) * (DIN / 32), I_UP = (D / 64) * (DFF / 32), I_DN = (DFF / 64) * (D / 32), I_SQ = (D / 64) * (D / 32), I_RG = 8;
    constexpr int NITEMS = I_IN + I_UP + I_DN + 3 * I_SQ + 16 * I_RG;
    unsigned char* ws = p.ws;
    for (int it = gw; it < NITEMS; it += NGW) {
        int r = it;
        if (r < I_IN) { p0_transpose_item(p.w_in, D, DIN, (bf16_t*)(ws + WS_WIN), 0, scr, r, lane); continue; } r -= I_IN;
        if (r < I_UP) { p0_transpose_item(p.w_up, D, DFF, (bf16_t*)(ws + WS_WUP), 0, scr, r, lane); continue; } r -= I_UP;
        if (r < I_DN) { p0_transpose_item(p.w_down, DFF, D, (bf16_t*)(ws + WS_WDN), 0, scr, r, lane); continue; } r -= I_DN;
        if (r < I_SQ) { p0_transpose_item(p.w_a, D, D, (bf16_t*)(ws + WS_WA), 0, scr, r, lane); continue; } r -= I_SQ;
        if (r < I_SQ) { p0_transpose_item(p.w_b, D, D, (bf16_t*)(ws + WS_WB), 0, scr, r, lane); continue; } r -= I_SQ;
        if (r < I_SQ) { p0_transpose_item(p.w_out, D, D, (bf16_t*)(ws + WS_WOUT), 0, scr, r, lane); continue; } r -= I_SQ;
        { const int hm = r / I_RG, ii = r % I_RG, h = hm >> 1, which = hm & 1;
          p0_transpose_item((which ? p.ig_w : p.rg_w) + (size_t)h * 128 * 128, 128, 128, (bf16_t*)(ws + WS_WRG), h * 256 + which * 128, scr, ii, lane); }
    }
    bf16_t* XN = (bf16_t*)((unsigned char*)p.out + OFF_SS * 4);
    for (int m = gw; m < M_PAD; m += NGW) {
        bf16_t* orow = XN + (size_t)m * D;
        if (m < M_REAL) {
            const float* xrow = m < ROW_SAMPLE ? p.x_prompt + (size_t)m * D : m < M_MAIN ? p.x_sample + (size_t)(m - ROW_SAMPLE) * D : p.meta + (size_t)(m - ROW_META) * D;
            rms_row_to_bf16(xrow, p.gains, orow, lane);
        } else {
            u32x2* o8 = (u32x2*)orow + lane;
#pragma unroll
            for (int j = 0; j < 4; ++j) o8[64 * j] = (u32x2){0u, 0u};
        }
    }
}

__device__ __forceinline__ float softplus_neg(float lam) {
    const float x = __expf(-lam);
    return x < 0.03f ? x * (1.0f - x * (0.5f - x * (1.0f / 3.0f - 0.25f * x))) : __logf(1.0f + x);
}
__device__ __forceinline__ float neg_expm1(float y) {
    if (y > -0.3f) { float q = 1.0f / 5040.0f; q = q * y + 1.0f / 720.0f; q = q * y + 1.0f / 120.0f; q = q * y + 1.0f / 24.0f; q = q * y + 1.0f / 6.0f; q = q * y + 0.5f; q = q * y + 1.0f; return -y * q; }
    return 1.0f - __expf(y);
}
constexpr int RG_WB = 0, RG_UCB = 69632, RG_UCF = 87040;
__device__ __forceinline__ void rg_phase(const Params& p, LAS unsigned char* lds, int mode, int wg, int nwg) {
    const int tid = threadIdx.x, lane = tid & 63, w = __builtin_amdgcn_readfirstlane(tid >> 6), fr = lane & 15, fq = lane >> 4;
    const int h = wg & 7, idx = wg >> 3, nidx = nwg >> 3;
    unsigned char* ws = p.ws;
    const bf16_t* U = (const bf16_t*)(ws + WS_GRP0 + G_U * GRP_BYTES);
    bf16_t* GA = (bf16_t*)(ws + WS_GRP0 + G_GA * GRP_BYTES);
    float* AGGA = (float*)(ws + WS_AGGA); float* AGGB = (float*)(ws + WS_AGGB);
    LAS unsigned char* WB = lds + RG_WB; LAS unsigned char* UCB = lds + RG_UCB; LAS float* UCF = (LAS float*)(lds + RG_UCF);
    __syncthreads();
    {   const bf16_t* wsrc = (const bf16_t*)(ws + WS_WRG) + (size_t)h * 256 * 128;
#pragma unroll
        for (int it = 0; it < 8; ++it) { const int row = (tid >> 4) + 32 * it, ch = tid & 15; *(LAS u32x4*)(WB + row * 272 + ch * 16) = *(const u32x4*)(wsrc + row * 128 + ch * 8); }
    }
    __syncthreads();
    bf16x8 bw[2][4];
#pragma unroll
    for (int nt = 0; nt < 2; ++nt)
#pragma unroll
        for (int ks = 0; ks < 4; ++ks) bw[nt][ks] = *(const LAS bf16x8*)(WB + (nt * 128 + 16 * w + fr) * 272 + 64 * ks + 16 * fq);
    const int c0 = h * 128 + 16 * w + 4 * fq;
    const f32x4 rgb = *(const f32x4*)(p.rg_b + c0), igb = *(const f32x4*)(p.ig_b + c0), lam4 = *(const f32x4*)(p.lam + c0);
    f32x4 sp8;
#pragma unroll
    for (int i = 0; i < 4; ++i) sp8[i] = 8.0f * softplus_neg(lam4[i]);
    const int nunits = mode == 0 ? NB * 33 + 16 : NB * 32;
    const int crow = tid >> 3, cgp = tid & 7, ch0 = h * 128 + 16 * cgp;
    for (int ui = idx; ui < nunits; ui += nidx) {
        int b = 0, j = 0, st = 0; bool sample = false, full = true;
        if (mode == 0) { if (ui < NB * 33) { b = ui / 33; j = ui % 33; full = false; } else { sample = true; st = ui - NB * 33; } }
        else { b = ui >> 5; j = (ui & 31) + 1; }
        {
            float uc[16];
            {   const f32x4* cb = (const f32x4*)(p.conv_b + ch0);
#pragma unroll
                for (int q = 0; q < 4; ++q) { const f32x4 v = cb[q]; uc[4 * q] = v.x; uc[4 * q + 1] = v.y; uc[4 * q + 2] = v.z; uc[4 * q + 3] = v.w; } }
            const bool rowvalid = sample || j > 0 || crow < 16;
#pragma unroll
            for (int k = 0; k < 4; ++k) {
                const bf16_t* src = nullptr; const float* srcf = nullptr;
                if (sample) { const int seg = crow >> 3, t = crow & 7, db = 8 * st + seg, ts = t + k - 3;
                    if (ts >= 0) src = U + (size_t)(ROW_SAMPLE + db * 8 + ts) * 1024 + ch0; else srcf = p.state_conv + ((size_t)db * 3 + ts + 3) * 1024 + ch0; }
                else { const int pp = (j == 0 ? crow : 16 + 64 * (j - 1) + crow) + k - 3;
                    if (rowvalid && pp >= 0) { const size_t grow = pp < 16 ? (size_t)(ROW_META + pp) : (size_t)b * 2048 + pp - 16; src = U + grow * 1024 + ch0; } }
                float val[16];
                if (src) { const u32x4 a = ((const u32x4*)src)[0], b2 = ((const u32x4*)src)[1];
                    val[0] = bflo(a.x); val[1] = bfhi(a.x); val[2] = bflo(a.y); val[3] = bfhi(a.y); val[4] = bflo(a.z); val[5] = bfhi(a.z); val[6] = bflo(a.w); val[7] = bfhi(a.w);
                    val[8] = bflo(b2.x); val[9] = bfhi(b2.x); val[10] = bflo(b2.y); val[11] = bfhi(b2.y); val[12] = bflo(b2.z); val[13] = bfhi(b2.z); val[14] = bflo(b2.w); val[15] = bfhi(b2.w); }
                else if (srcf) {
#pragma unroll
                    for (int q = 0; q < 4; ++q) { const f32x4 v = ((const f32x4*)srcf)[q]; val[4 * q] = v.x; val[4 * q + 1] = v.y; val[4 * q + 2] = v.z; val[4 * q + 3] = v.w; } }
                else {
#pragma unroll
                    for (int e = 0; e < 16; ++e) val[e] = 0.f; }
                const f32x4* cw = (const f32x4*)(p.conv_w + (size_t)k * 1024 + ch0);
#pragma unroll
                for (int q = 0; q < 4; ++q) { const f32x4 wv = cw[q]; uc[4 * q] += wv.x * val[4 * q]; uc[4 * q + 1] += wv.y * val[4 * q + 1]; uc[4 * q + 2] += wv.z * val[4 * q + 2]; uc[4 * q + 3] += wv.w * val[4 * q + 3]; }
            }
            if (!rowvalid) {
#pragma unroll
                for (int e = 0; e < 16; ++e) uc[e] = 0.f; }
#pragma unroll
            for (int q = 0; q < 4; ++q) *(LAS f32x4*)(UCF + crow * 132 + 16 * cgp + 4 * q) = (f32x4){uc[4 * q], uc[4 * q + 1], uc[4 * q + 2], uc[4 * q + 3]};
            u32x4 o0, o1;
            o0.x = cvt_pk_bf16(uc[0], uc[1]); o0.y = cvt_pk_bf16(uc[2], uc[3]); o0.z = cvt_pk_bf16(uc[4], uc[5]); o0.w = cvt_pk_bf16(uc[6], uc[7]);
            o1.x = cvt_pk_bf16(uc[8], uc[9]); o1.y = cvt_pk_bf16(uc[10], uc[11]); o1.z = cvt_pk_bf16(uc[12], uc[13]); o1.w = cvt_pk_bf16(uc[14], uc[15]);
            *(LAS u32x4*)(UCB + crow * 272 + 32 * cgp) = o0; *(LAS u32x4*)(UCB + crow * 272 + 32 * cgp + 16) = o1;
        }
        __syncthreads();
        f32x4 accr[4], acci[4];
#pragma unroll
        for (int m = 0; m < 4; ++m) { accr[m] = (f32x4){0.f, 0.f, 0.f, 0.f}; acci[m] = (f32x4){0.f, 0.f, 0.f, 0.f}; }
#pragma unroll
        for (int m = 0; m < 4; ++m)
#pragma unroll
            for (int ks = 0; ks < 4; ++ks) { const bf16x8 af = *(const LAS bf16x8*)(UCB + (16 * m + fr) * 272 + 64 * ks + 16 * fq);
                accr[m] = mfma16(bw[0][ks], af, accr[m]); acci[m] = mfma16(bw[1][ks], af, acci[m]); }
        float a[4][4], bb[4][4];
#pragma unroll
        for (int m = 0; m < 4; ++m) {
            const int row = 16 * m + fr;
            const f32x4 ucv = *(const LAS f32x4*)(UCF + row * 132 + 16 * w + 4 * fq);
            const bool valid = sample || j > 0 || row < 16;
            const bool first = !sample && j == 0 && row == 0;
#pragma unroll
            for (int i = 0; i < 4; ++i) {
                const float r = fsig(accr[m][i] + rgb[i]), ig = fsig(acci[m][i] + igb[i]);
                const float la = -r * sp8[i];
                const float av = __expf(la);
                float mult = sqrtf(neg_expm1(2.0f * la));
                if (first) mult = 1.0f;
                a[m][i] = valid ? av : 1.0f; bb[m][i] = valid ? mult * ig * ucv[i] : 0.0f;
            }
        }
        if (!sample) {
#pragma unroll
            for (int m = 0; m < 4; ++m)
#pragma unroll
                for (int i = 0; i < 4; ++i)
#pragma unroll
                    for (int d = 1; d < 16; d <<= 1) { const float ap = __shfl_up(a[m][i], d, 16), bp = __shfl_up(bb[m][i], d, 16); if (fr >= d) { bb[m][i] = a[m][i] * bp + bb[m][i]; a[m][i] = a[m][i] * ap; } }
            float ca[4] = {1.f, 1.f, 1.f, 1.f}, cb[4] = {0.f, 0.f, 0.f, 0.f};
#pragma unroll
            for (int m = 0; m < 4; ++m)
#pragma unroll
                for (int i = 0; i < 4; ++i) { bb[m][i] = a[m][i] * cb[i] + bb[m][i]; a[m][i] = a[m][i] * ca[i]; ca[i] = __shfl(a[m][i], 15, 16); cb[i] = __shfl(bb[m][i], 15, 16); }
        } else {
#pragma unroll
            for (int m = 0; m < 4; ++m)
#pragma unroll
                for (int i = 0; i < 4; ++i)
#pragma unroll
                    for (int d = 1; d < 8; d <<= 1) { const float ap = __shfl_up(a[m][i], d, 8), bp = __shfl_up(bb[m][i], d, 8); if ((fr & 7) >= d) { bb[m][i] = a[m][i] * bp + bb[m][i]; a[m][i] = a[m][i] * ap; } }
        }
        if (!full) {
            if (fr == 15) { const size_t o = ((size_t)b * 33 + j) * 1024 + c0;
                *(f32x4*)(AGGA + o) = (f32x4){a[3][0], a[3][1], a[3][2], a[3][3]}; *(f32x4*)(AGGB + o) = (f32x4){bb[3][0], bb[3][1], bb[3][2], bb[3][3]}; }
        } else {
            f32x4 hin = (f32x4){0.f, 0.f, 0.f, 0.f};
            if (!sample) { for (int jj = 0; jj < j; ++jj) { const size_t o = ((size_t)b * 33 + jj) * 1024 + c0; const f32x4 A4 = *(const f32x4*)(AGGA + o), B4 = *(const f32x4*)(AGGB + o); hin = A4 * hin + B4; } }
#pragma unroll
            for (int m = 0; m < 4; ++m) {
                const int row = 16 * m + fr;
                size_t grow;
                if (sample) { const int db = 8 * st + (row >> 3); hin = *(const f32x4*)(p.state_rglru + (size_t)db * 1024 + c0); grow = (size_t)ROW_SAMPLE + 64 * st + row; }
                else grow = (size_t)b * 2048 + 64 * (j - 1) + row;
                f32x4 hv;
#pragma unroll
                for (int i = 0; i < 4; ++i) hv[i] = a[m][i] * hin[i] + bb[m][i];
                bf16_t* gp = GA + grow * 1024 + c0;
                const u32x2 g = *(const u32x2*)gp;
                u32x2 y; y.x = cvt_pk_bf16(hv[0] * bflo(g.x), hv[1] * bfhi(g.x)); y.y = cvt_pk_bf16(hv[2] * bflo(g.y), hv[3] * bfhi(g.y));
                *(u32x2*)gp = y;
                if (sample) { if ((fr & 7) == 7) { const int db = 8 * st + (row >> 3); *(f32x4*)(p.out + OFF_HS + (size_t)db * 1024 + c0) = hv; } }
                else if (j == 32 && m == 3 && fr == 15) *(f32x4*)(p.out + OFF_HP + (size_t)b * 1024 + c0) = hv;
            }
        }
        __syncthreads();
    }
}

__device__ __forceinline__ void hgrn_sample_item(const Params& p, LAS unsigned char* lds, int db, int h) {
    const int tid = threadIdx.x;
    unsigned char* ws = p.ws;
    const bf16_t* Qb = (const bf16_t*)(ws + WS_GRP0 + G_Q * GRP_BYTES); const bf16_t* LFb = (const bf16_t*)(ws + WS_GRP0 + G_LF * GRP_BYTES);
    bf16_t* Vb = (bf16_t*)(ws + WS_GRP0 + G_V * GRP_BYTES);
    LAS float* FF = (LAS float*)lds; LAS float* KK = FF + 1024; LAS float* QQ = KK + 1024; LAS float* VV = QQ + 1024; LAS float* ORED = VV + 1024;
    const size_t row0 = (size_t)ROW_SAMPLE + db * 8;
    {   const int k = tid & 127, tq = tid >> 7;
#pragma unroll
        for (int tt = 0; tt < 2; ++tt) { const int t = 2 * tq + tt; const size_t off = (row0 + t) * 1024 + h * 128 + k;
            const float fg = __expf(bf2f(LFb[off])); FF[k * 8 + t] = fg; KK[k * 8 + t] = 1.0f - fg; QQ[k * 8 + t] = bf2f(Qb[off]); VV[t * 128 + k] = bf2f(Vb[off]); }
    }
    const int kq = tid >> 5, v4 = tid & 31;
    __syncthreads();
    f32x4 O[8];
#pragma unroll
    for (int t = 0; t < 8; ++t) O[t] = (f32x4){0.f, 0.f, 0.f, 0.f};
    const size_t sbase = ((size_t)(db * 8 + h) * 128 + 8 * kq) * 128 + 4 * v4;
    const float* S0 = p.state_hgrn + sbase;
    float* S1 = p.out + OFF_SS + sbase;
    f32x4 S4[8];
#pragma unroll
    for (int kk = 0; kk < 8; ++kk) S4[kk] = *(const f32x4*)(S0 + kk * 128);
#pragma unroll 1
    for (int kk = 0; kk < 8; ++kk) {
        const int k = 8 * kq + kk;
        const f32x4 f0 = *(const LAS f32x4*)(FF + k * 8), f1 = *(const LAS f32x4*)(FF + k * 8 + 4), k0 = *(const LAS f32x4*)(KK + k * 8), k1 = *(const LAS f32x4*)(KK + k * 8 + 4),
                    q0 = *(const LAS f32x4*)(QQ + k * 8), q1 = *(const LAS f32x4*)(QQ + k * 8 + 4);
        f32x4 s = S4[0];
#pragma unroll
        for (int t = 0; t < 8; ++t) { const float ft = t < 4 ? f0[t & 3] : f1[t & 3], kt = t < 4 ? k0[t & 3] : k1[t & 3], qt = t < 4 ? q0[t & 3] : q1[t & 3];
            const f32x4 vt = *(const LAS f32x4*)(VV + t * 128 + 4 * v4);
            s = s * ft + vt * kt; O[t] += s * qt; }
        *(f32x4*)(S1 + kk * 128) = s;
#pragma unroll
        for (int r = 0; r < 7; ++r) S4[r] = S4[r + 1];
    }
#pragma unroll
    for (int t = 0; t < 8; ++t) *(LAS f32x4*)(ORED + (kq * 8 + t) * 128 + 4 * v4) = O[t];
    __syncthreads();
    {   const int t = tid >> 6, vp = tid & 63; float o0 = 0.f, o1 = 0.f;
#pragma unroll
        for (int g = 0; g < 16; ++g) { o0 += ORED[(g * 8 + t) * 128 + 2 * vp]; o1 += ORED[(g * 8 + t) * 128 + 2 * vp + 1]; }
        *(unsigned*)(Vb + (row0 + t) * 1024 + h * 128 + 2 * vp) = cvt_pk_bf16(o0, o1);
    }
    __syncthreads();
}

constexpr int HC_QM = 0, HC_KM = 8704, HC_KMT = 17408, HC_VT = 27648, HC_E1 = 37888, HC_E2 = 38400, HC_GT = 38912;
__device__ __forceinline__ void hgrn_chain(const Params& p, LAS unsigned char* lds, int b, int h) {
    const int tid = threadIdx.x, lane = tid & 63, w = __builtin_amdgcn_readfirstlane(tid >> 6), fr = lane & 15, fq = lane >> 4;
    unsigned char* ws = p.ws;
    const bf16_t* Qb = (const bf16_t*)(ws + WS_GRP0 + G_Q * GRP_BYTES); const bf16_t* LFb = (const bf16_t*)(ws + WS_GRP0 + G_LF * GRP_BYTES);
    bf16_t* Vb = (bf16_t*)(ws + WS_GRP0 + G_V * GRP_BYTES);
    LAS bf16_t* QM = (LAS bf16_t*)(lds + HC_QM); LAS bf16_t* KM = (LAS bf16_t*)(lds + HC_KM); LAS bf16_t* KMT = (LAS bf16_t*)(lds + HC_KMT); LAS bf16_t* VT = (LAS bf16_t*)(lds + HC_VT);
    LAS float* E1 = (LAS float*)(lds + HC_E1); LAS float* E2 = (LAS float*)(lds + HC_E2); LAS float* GT = (LAS float*)(lds + HC_GT);
    const int k = tid & 127, tg = tid >> 7;
    int kperm; { const int x = k & 31; kperm = (k & ~31) + (x < 16 ? 8 * (x >> 2) + (x & 3) : 8 * ((x - 16) >> 2) + 4 + (x & 3)); }
    f32x4 S[8];
#pragma unroll
    for (int kt = 0; kt < 8; ++kt) S[kt] = (f32x4){0.f, 0.f, 0.f, 0.f};
    __syncthreads();
    for (int c = 0; c < 65; ++c) {
        const int ntok = c == 0 ? 16 : 32;
        const size_t row0 = c == 0 ? (size_t)ROW_META : (size_t)b * 2048 + 32 * (c - 1);
        float q[8], lf[8], vv[8];
#pragma unroll
        for (int j = 0; j < 8; ++j) { const int t = 8 * tg + j;
            if (t < ntok) { const size_t off = (row0 + t) * 1024 + h * 128 + k; q[j] = bf2f(Qb[off]); lf[j] = bf2f(LFb[off]); vv[j] = bf2f(Vb[off]); } else { q[j] = 0.f; lf[j] = 0.f; vv[j] = 0.f; } }
        float cs[8]; { float run = 0.f;
#pragma unroll
            for (int j = 0; j < 8; ++j) { run += lf[j]; cs[j] = run; } }
        GT[tg * 128 + k] = cs[7];
        __syncthreads();
        {   const float g0 = GT[k], g1 = GT[128 + k], g2 = GT[256 + k], g3 = GT[384 + k];
            const float pre = tg == 0 ? 0.f : tg == 1 ? g0 : tg == 2 ? g0 + g1 : g0 + g1 + g2;
            const float b15 = g0 + g1, b31 = b15 + g2 + g3;
#pragma unroll
            for (int j = 0; j < 8; ++j) { const int t = 8 * tg + j; const float bt = pre + cs[j];
                const float qm = q[j] * __expf(bt - b15), km = (1.0f - __expf(lf[j])) * __expf(b15 - bt);
                const bf16_t kmb = f2bf(km);
                QM[t * 136 + kperm] = f2bf(qm); KM[t * 136 + kperm] = kmb; KMT[k * 40 + t] = kmb; VT[k * 40 + t] = f2bf(vv[j]); }
            if (tg == 0) { E1[k] = __expf(b15); E2[k] = __expf(b31 - b15); }
        }
        __syncthreads();
#pragma unroll
        for (int kt = 0; kt < 8; ++kt) { const f32x4 e = *(const LAS f32x4*)(E1 + 16 * kt + 4 * fq); S[kt] = S[kt] * e; }
        bf16x8 qf[2][4], kf[2][4];
#pragma unroll
        for (int mt = 0; mt < 2; ++mt)
#pragma unroll
            for (int ks = 0; ks < 4; ++ks) { qf[mt][ks] = *(const LAS bf16x8*)(QM + (16 * mt + fr) * 136 + 32 * ks + 8 * fq); kf[mt][ks] = *(const LAS bf16x8*)(KM + (16 * mt + fr) * 136 + 32 * ks + 8 * fq); }
        f32x4 a00 = (f32x4){0.f, 0.f, 0.f, 0.f}, a10 = a00, a11 = a00;
#pragma unroll
        for (int ks = 0; ks < 4; ++ks) { a00 = mfma16(kf[0][ks], qf[0][ks], a00); a10 = mfma16(kf[0][ks], qf[1][ks], a10); a11 = mfma16(kf[1][ks], qf[1][ks], a11); }
#pragma unroll
        for (int i = 0; i < 4; ++i) { if (4 * fq + i > fr) { a00[i] = 0.f; a11[i] = 0.f; } }
        bf16x8 aop0, aop1;
        {   union { u32x4 u; bf16x8 v; } c0, c1;
            c0.u.x = cvt_pk_bf16(a00[0], a00[1]); c0.u.y = cvt_pk_bf16(a00[2], a00[3]); c0.u.z = 0u; c0.u.w = 0u;
            c1.u.x = cvt_pk_bf16(a10[0], a10[1]); c1.u.y = cvt_pk_bf16(a10[2], a10[3]); c1.u.z = cvt_pk_bf16(a11[0], a11[1]); c1.u.w = cvt_pk_bf16(a11[2], a11[3]);
            aop0 = c0.v; aop1 = c1.v; }
        f32x4 o0 = (f32x4){0.f, 0.f, 0.f, 0.f}, o1 = o0;
#pragma unroll
        for (int ks = 0; ks < 4; ++ks) { union { u32x4 u; bf16x8 v; } sf;
            sf.u.x = cvt_pk_bf16(S[2 * ks][0], S[2 * ks][1]); sf.u.y = cvt_pk_bf16(S[2 * ks][2], S[2 * ks][3]); sf.u.z = cvt_pk_bf16(S[2 * ks + 1][0], S[2 * ks + 1][1]); sf.u.w = cvt_pk_bf16(S[2 * ks + 1][2], S[2 * ks + 1][3]);
            o0 = mfma16(sf.v, qf[0][ks], o0); o1 = mfma16(sf.v, qf[1][ks], o1); }
        {   union { u32x4 u; bf16x8 v; } vs;
            const u32x2 lo = *(const LAS u32x2*)(VT + (16 * w + fr) * 40 + 4 * fq), hi = *(const LAS u32x2*)(VT + (16 * w + fr) * 40 + 16 + 4 * fq);
            vs.u.x = lo.x; vs.u.y = lo.y; vs.u.z = hi.x; vs.u.w = hi.y;
            o0 = mfma16(vs.v, aop0, o0); o1 = mfma16(vs.v, aop1, o1); }
        if (c > 0) {
            u32x2 y0, y1; y0.x = cvt_pk_bf16(o0[0], o0[1]); y0.y = cvt_pk_bf16(o0[2], o0[3]); y1.x = cvt_pk_bf16(o1[0], o1[1]); y1.y = cvt_pk_bf16(o1[2], o1[3]);
            *(u32x2*)(Vb + (row0 + fr) * 1024 + h * 128 + 16 * w + 4 * fq) = y0; *(u32x2*)(Vb + (row0 + 16 + fr) * 1024 + h * 128 + 16 * w + 4 * fq) = y1; }
        {   const bf16x8 vn = *(const LAS bf16x8*)(VT + (16 * w + fr) * 40 + 8 * fq);
#pragma unroll
            for (int kt = 0; kt < 8; ++kt) { const bf16x8 kmt = *(const LAS bf16x8*)(KMT + (16 * kt + fr) * 40 + 8 * fq); S[kt] = mfma16(kmt, vn, S[kt]);
                const f32x4 e = *(const LAS f32x4*)(E2 + 16 * kt + 4 * fq); S[kt] = S[kt] * e; } }
        __syncthreads();
    }
    float* SP = p.out + OFF_SP + ((size_t)(b * 8 + h) * 128) * 128;
#pragma unroll
    for (int kt = 0; kt < 8; ++kt)
#pragma unroll
        for (int i = 0; i < 4; ++i) SP[(size_t)(16 * kt + 4 * fq + i) * 128 + 16 * w + fr] = S[kt][i];
}

__device__ __forceinline__ void p2c_finish(const Params& p) {
    const int tid = threadIdx.x, lane = tid & 63, wave = tid >> 6;
    const int gw = blockIdx.x * NWAVES + wave, NGW = gridDim.x * NWAVES;
    unsigned char* ws = p.ws;
    const bf16_t* Vb = (const bf16_t*)(ws + WS_GRP0 + G_V * GRP_BYTES); bf16_t* OG = (bf16_t*)(ws + WS_GRP0 + G_OG * GRP_BYTES);
    const bf16_t* U = (const bf16_t*)(ws + WS_GRP0 + G_U * GRP_BYTES);
    float gn[16];
#pragma unroll
    for (int q = 0; q < 4; ++q) { const f32x4 v = *(const f32x4*)(p.gnorm + 16 * lane + 4 * q); gn[4 * q] = v.x; gn[4 * q + 1] = v.y; gn[4 * q + 2] = v.z; gn[4 * q + 3] = v.w; }
    for (int m = gw; m < M_MAIN; m += NGW) {
        const u32x4* op = (const u32x4*)(Vb + (size_t)m * 1024 + 16 * lane); u32x4* gp = (u32x4*)(OG + (size_t)m * 1024 + 16 * lane);
        const u32x4 oa = op[0], ob = op[1], ga = gp[0], gb = gp[1];
        float o[16], g[16];
        o[0] = bflo(oa.x); o[1] = bfhi(oa.x); o[2] = bflo(oa.y); o[3] = bfhi(oa.y); o[4] = bflo(oa.z); o[5] = bfhi(oa.z); o[6] = bflo(oa.w); o[7] = bfhi(oa.w);
        o[8] = bflo(ob.x); o[9] = bfhi(ob.x); o[10] = bflo(ob.y); o[11] = bfhi(ob.y); o[12] = bflo(ob.z); o[13] = bfhi(ob.z); o[14] = bflo(ob.w); o[15] = bfhi(ob.w);
        g[0] = bflo(ga.x); g[1] = bfhi(ga.x); g[2] = bflo(ga.y); g[3] = bfhi(ga.y); g[4] = bflo(ga.z); g[5] = bfhi(ga.z); g[6] = bflo(ga.w); g[7] = bfhi(ga.w);
        g[8] = bflo(gb.x); g[9] = bfhi(gb.x); g[10] = bflo(gb.y); g[11] = bfhi(gb.y); g[12] = bflo(gb.z); g[13] = bfhi(gb.z); g[14] = bflo(gb.w); g[15] = bfhi(gb.w);
        float ss = 0.f;
#pragma unroll
        for (int e = 0; e < 16; ++e) ss += o[e] * o[e];
        ss += __shfl_xor(ss, 1); ss += __shfl_xor(ss, 2); ss += __shfl_xor(ss, 4);
        const float rstd = 1.0f / sqrtf(ss * (1.0f / 128.0f) + EPS);
        float y[16];
#pragma unroll
        for (int e = 0; e < 16; ++e) y[e] = o[e] * rstd * gn[e] * g[e];
        u32x4 ya, yb;
        ya.x = cvt_pk_bf16(y[0], y[1]); ya.y = cvt_pk_bf16(y[2], y[3]); ya.z = cvt_pk_bf16(y[4], y[5]); ya.w = cvt_pk_bf16(y[6], y[7]);
        yb.x = cvt_pk_bf16(y[8], y[9]); yb.y = cvt_pk_bf16(y[10], y[11]); yb.z = cvt_pk_bf16(y[12], y[13]); yb.w = cvt_pk_bf16(y[14], y[15]);
        gp[0] = ya; gp[1] = yb;
    }
    const int gt = blockIdx.x * NTHREADS + tid, NGT = gridDim.x * NTHREADS;
    for (int e = gt; e < (NB + DBATCH) * 3 * 1024; e += NGT) {
        const int c = e & 1023, rk = e >> 10, sq = rk / 3, kk = rk % 3;
        if (sq < NB) p.out[OFF_CONVP + (size_t)(sq * 3 + kk) * 1024 + c] = bf2f(U[((size_t)sq * 2048 + 2045 + kk) * 1024 + c]);
        else { const int db = sq - NB; p.out[OFF_CONVS + (size_t)(db * 3 + kk) * 1024 + c] = bf2f(U[((size_t)ROW_SAMPLE + db * 8 + 5 + kk) * 1024 + c]); }
    }
}

__device__ __forceinline__ void p4b_rows(const Params& p) {
    const int tid = threadIdx.x, lane = tid & 63, wave = tid >> 6;
    const int gw = blockIdx.x * NWAVES + wave, NGW = gridDim.x * NWAVES;
    const float* MO = (const float*)(p.ws + WS_GRP0 + G_LF * GRP_BYTES);
    bf16_t* HN = (bf16_t*)(p.ws + WS_GRP0 + G_U * GRP_BYTES);
    const f32x4* g1 = (const f32x4*)(p.gains + 1024) + lane; const f32x4* g2 = (const f32x4*)(p.gains + 2048) + lane;
    for (int m = gw; m < M_MAIN; m += NGW) {
        const float* xrow = m < ROW_SAMPLE ? p.x_prompt + (size_t)m * D : p.x_sample + (size_t)(m - ROW_SAMPLE) * D;
        const f32x4* mr = (const f32x4*)(MO + (size_t)m * D) + lane; const f32x4* xr = (const f32x4*)xrow + lane;
        f32x4 v[4], x[4]; float s = 0.f;
#pragma unroll
        for (int j = 0; j < 4; ++j) { v[j] = mr[64 * j]; x[j] = xr[64 * j]; s += (v[j].x * v[j].x + v[j].y * v[j].y) + (v[j].z * v[j].z + v[j].w * v[j].w); }
        const float rstd = 1.0f / sqrtf(wave_sum(s) * (1.f / D) + EPS);
        float s2 = 0.f;
        f32x4* orow = (f32x4*)(p.out + OFF_Y + (size_t)m * D) + lane;
#pragma unroll
        for (int j = 0; j < 4; ++j) { const f32x4 gg = g1[64 * j]; x[j] = x[j] + v[j] * rstd * gg; orow[64 * j] = x[j]; s2 += (x[j].x * x[j].x + x[j].y * x[j].y) + (x[j].z * x[j].z + x[j].w * x[j].w); }
        const float rstd2 = 1.0f / sqrtf(wave_sum(s2) * (1.f / D) + EPS);
        u32x2* o8 = (u32x2*)(HN + (size_t)m * D) + lane;
#pragma unroll
        for (int j = 0; j < 4; ++j) { const f32x4 gg = g2[64 * j]; u32x2 wv; wv.x = cvt_pk_bf16(x[j].x * rstd2 * gg.x, x[j].y * rstd2 * gg.y); wv.y = cvt_pk_bf16(x[j].z * rstd2 * gg.z, x[j].w * rstd2 * gg.w); o8[64 * j] = wv; }
    }
}
__device__ __forceinline__ void p7_rows(const Params& p) {
    const int tid = threadIdx.x, lane = tid & 63, wave = tid >> 6;
    const int gw = blockIdx.x * NWAVES + wave, NGW = gridDim.x * NWAVES;
    const float* FFB = (const float*)(p.ws + WS_GRP0 + G_U * GRP_BYTES);
    const f32x4* g3 = (const f32x4*)(p.gains + 3072) + lane;
    for (int m = gw; m < M_MAIN; m += NGW) {
        const f32x4* fr_ = (const f32x4*)(FFB + (size_t)m * D) + lane;
        f32x4* orow = (f32x4*)(p.out + OFF_Y + (size_t)m * D) + lane;
        f32x4 v[4], x[4]; float s = 0.f;
#pragma unroll
        for (int j = 0; j < 4; ++j) { v[j] = fr_[64 * j]; x[j] = orow[64 * j]; s += (v[j].x * v[j].x + v[j].y * v[j].y) + (v[j].z * v[j].z + v[j].w * v[j].w); }
        const float rstd = 1.0f / sqrtf(wave_sum(s) * (1.f / D) + EPS);
#pragma unroll
        for (int j = 0; j < 4; ++j) { const f32x4 gg = g3[64 * j]; f32x4 r = x[j] + v[j] * rstd * gg;
#ifdef SANITIZE
#pragma unroll
            for (int e = 0; e < 4; ++e) if (!(fabsf(r[e]) < 1e30f)) r[e] = 1000.0f;
#endif
            orow[64 * j] = r; }
    }
}

__global__ void __launch_bounds__(NTHREADS, 2) fwd(Params p) {
    extern __shared__ __attribute__((aligned(16))) unsigned char lds_raw[];
    LAS unsigned char* lds = (LAS unsigned char*)lds_raw;
    unsigned char* ws = p.ws;
    const int G = gridDim.x, bid = blockIdx.x;
#ifndef PHMASK
#define PHMASK 0xFFF
#endif
#define IN(k) (((PHMASK >> (k)) & 1) && p.ph_lo <= (k) && (k) < p.ph_hi)
#define SEAM(k) do { if (p.use_bar && IN(k) && IN((k) + 1)) { cg::this_grid().sync(); } } while (0)
    bf16_t* GRP[6];
#pragma unroll
    for (int g = 0; g < 6; ++g) GRP[g] = (bf16_t*)(ws + WS_GRP0 + (size_t)g * GRP_BYTES);

    if (IN(0)) p0_prologue(p, lds);
    SEAM(0);
    if (IN(1)) {
        pg8::Gemm g{(const bf16_t*)((unsigned char*)p.out + OFF_SS * 4), (const bf16_t*)(ws + WS_WIN), M_PAD, DIN, D};
        pg8::StaticOrder S; S.init(M_PAD, DIN, G, bid);
        pg8::EpiProj E{ws, (unsigned char*)p.out, p.hgrn_lb};
        pg8::gemm_phase<pg8::EpiProj, pg8::StaticOrder, true, true>(lds, g, S, E);
    }
    SEAM(1);
    if (IN(2)) {
        rg_phase(p, lds, 0, bid, G);
    }
    SEAM(2);
    if (IN(3)) {
        if (bid < 64) hgrn_chain(p, lds, bid >> 3, bid & 7);
        else {
            for (int it = bid - 64; it < DBATCH * 8; it += G - 64) hgrn_sample_item(p, lds, it >> 3, it & 7);
            rg_phase(p, lds, 1, bid - 64, G - 64);
        }
    }
    SEAM(3);
    if (IN(4)) p2c_finish(p);
    SEAM(4);
    if (IN(5)) {
        pg8::Gemm g{GRP[G_GA], (const bf16_t*)(ws + WS_WA), M_MAIN, D, D};
        pg8::StaticOrder S; S.init(M_MAIN, D, G, bid);
        pg8::EpiGate<0> E{(const bf16_t*)p.out, nullptr, GRP[G_U]};
        pg8::gemm_phase<pg8::EpiGate<0>, pg8::StaticOrder, true, true>(lds, g, S, E);
    }
    SEAM(5);
    if (IN(6)) {
        pg8::Gemm g{GRP[G_OG], (const bf16_t*)(ws + WS_WB), M_MAIN, D, D};
        pg8::StaticOrder S; S.init(M_MAIN, D, G, bid);
        pg8::EpiGate<1> E{(const bf16_t*)((unsigned char*)p.out + GATE_BYTES), GRP[G_U], GRP[G_Q]};
        pg8::gemm_phase<pg8::EpiGate<1>, pg8::StaticOrder, true, true>(lds, g, S, E);
    }
    SEAM(6);
    if (IN(7)) {
        pg8::Gemm g{GRP[G_Q], (const bf16_t*)(ws + WS_WOUT), M_MAIN, D, D};
        pg8::StaticOrder S; S.init(M_MAIN, D, G, bid);
        pg8::EpiF32 E{(float*)GRP[G_LF]};
        pg8::gemm_phase<pg8::EpiF32, pg8::StaticOrder, true, true>(lds, g, S, E);
    }
    SEAM(7);
    if (IN(8)) p4b_rows(p);
    SEAM(8);
    if (IN(9)) {
        pg8::Gemm g{GRP[G_U], (const bf16_t*)(ws + WS_WUP), M_MAIN, DFF, D};
        pg8::StaticOrder S; S.init(M_MAIN, DFF, G, bid);
        pg8::EpiRelu2 E{GRP[G_Q]};
        pg8::gemm_phase<pg8::EpiRelu2, pg8::StaticOrder, true, true>(lds, g, S, E);
    }
    SEAM(9);
    if (IN(10)) {
        pg8::Gemm g{GRP[G_Q], (const bf16_t*)(ws + WS_WDN), M_MAIN, D, DFF};
        pg8::StaticOrder S; S.init(M_MAIN, D, G, bid);
        pg8::EpiF32 E{(float*)GRP[G_U]};
        pg8::gemm_phase<pg8::EpiF32, pg8::StaticOrder, true, true>(lds, g, S, E);
    }
    SEAM(10);
    if (IN(11)) p7_rows(p);
#undef IN
#undef SEAM
}

#ifndef N_LAUNCH_MODE
#define N_LAUNCH_MODE 1
#endif
extern "C" void kernel_launch(void* const* d_in, const int* in_sizes, int n_in, void* d_out, int out_size, void* d_ws, size_t ws_size, hipStream_t stream) {
    static int grid = 0;
    if (grid == 0) {
        if (n_in != 22 || (size_t)out_size != OUT_FLOATS || ws_size < WS_END) { fprintf(stderr, "kernel_launch: unexpected sizes (n_in %d, out %d, ws %zu); nothing launched\n", n_in, out_size, ws_size); grid = -1; return; }
        int dev = 0, cus = 0, per_cu = 0;
        if (hipGetDevice(&dev) != hipSuccess || hipDeviceGetAttribute(&cus, hipDeviceAttributeMultiprocessorCount, dev) != hipSuccess) { grid = -1; return; }
        if (hipFuncSetAttribute((const void*)fwd, hipFuncAttributeMaxDynamicSharedMemorySize, LDS_BYTES) != hipSuccess) { fprintf(stderr, "kernel_launch: hipFuncSetAttribute failed\n"); grid = -1; return; }
        if (hipOccupancyMaxActiveBlocksPerMultiprocessor(&per_cu, (const void*)fwd, NTHREADS, LDS_BYTES) != hipSuccess || per_cu < 1) { fprintf(stderr, "kernel_launch: occupancy query failed (%d)\n", per_cu); (void)hipGetLastError(); grid = -1; return; }
        grid = cus;
        if (grid != 256) fprintf(stderr, "kernel_launch: %d CUs; this kernel is laid out for 256\n", grid);
    }
    if (grid < 0) return;
    (void)hipMemsetAsync((char*)d_ws + WS_CTL, 0, CTL_ZERO_BYTES, stream);
    Params p{};
    const float** pp = (const float**)&p;
    for (int i = 0; i < 22; ++i) pp[i] = (const float*)d_in[i];
    p.out = (float*)d_out; p.ws = (unsigned char*)d_ws;
#if N_LAUNCH_MODE == 1
    p.ph_lo = 0; p.ph_hi = NPHASES; p.use_bar = 1;
    void* args[] = {&p};
    hipError_t e = hipLaunchCooperativeKernel((const void*)fwd, dim3(grid), dim3(NTHREADS), args, LDS_BYTES, stream);
    if (e != hipSuccess) fprintf(stderr, "kernel_launch: cooperative launch failed: %s (grid %d)\n", hipGetErrorString(e), grid);
#else
#ifndef NPH_RUN
#define NPH_RUN NPHASES
#endif
    for (int ph = 0; ph < NPH_RUN; ++ph) {
        p.ph_lo = ph; p.ph_hi = ph + 1; p.use_bar = 0;
        hipLaunchKernelGGL(fwd, dim3(grid), dim3(NTHREADS), LDS_BYTES, stream, p);
    }
#ifdef DUMP_V
    (void)hipMemcpyAsync((char*)d_out, (char*)d_ws + WS_GRP0 + G_V * GRP_BYTES, GATE_BYTES, hipMemcpyDeviceToDevice, stream);
    (void)hipMemcpyAsync((char*)d_out + GATE_BYTES, (char*)d_ws + WS_GRP0 + G_V * GRP_BYTES, GATE_BYTES, hipMemcpyDeviceToDevice, stream);
#endif
#ifdef DUMP_YAB
    (void)hipMemcpyAsync((char*)d_out, (char*)d_ws + WS_GRP0 + G_GA * GRP_BYTES, GATE_BYTES, hipMemcpyDeviceToDevice, stream);
    (void)hipMemcpyAsync((char*)d_out + GATE_BYTES, (char*)d_ws + WS_GRP0 + G_OG * GRP_BYTES, GATE_BYTES, hipMemcpyDeviceToDevice, stream);
#endif
#ifdef DUMP_YA
    (void)hipMemcpyAsync((char*)d_out, (char*)d_ws + WS_GRP0 + G_GA * GRP_BYTES, GATE_BYTES, hipMemcpyDeviceToDevice, stream);
    (void)hipMemcpyAsync((char*)d_out + GATE_BYTES, (char*)d_ws + WS_GRP0 + G_GA * GRP_BYTES, GATE_BYTES, hipMemcpyDeviceToDevice, stream);
#endif
#endif
}
```

```cpp
#include <hip/hip_runtime.h>
#include <hip/hip_cooperative_groups.h>
#include <cstdio>
#include <cstdint>
namespace cg = cooperative_groups;

constexpr int D = 1024, NB = 8, SEQ = 2048, NMETA = 16, DBATCH = 128, DSEQ = 8, DIN = 8192, DFF = 4096;
constexpr int ROW_SAMPLE = NB * SEQ;
constexpr int M_MAIN = ROW_SAMPLE + DBATCH * DSEQ;
constexpr int ROW_META = M_MAIN;
constexpr int M_REAL = M_MAIN + NMETA;
constexpr int M_PAD = 17664;
constexpr float EPS = 1e-6f;

constexpr size_t MiB = 1u << 20;
constexpr size_t WS_CTL = 0, CTL_ZERO_BYTES = 1 * MiB;
constexpr size_t WS_WIN = 1 * MiB, WS_WUP = 17 * MiB, WS_WDN = 25 * MiB, WS_WA = 33 * MiB, WS_WB = 35 * MiB, WS_WOUT = 37 * MiB, WS_WRG = 39 * MiB;
constexpr size_t AGG_BYTES = (size_t)NB * 33 * 1024 * 4;
constexpr size_t WS_AGGA = 39 * MiB + 512 * 1024, WS_AGGB = WS_AGGA + AGG_BYTES;
constexpr size_t GRP_BYTES = (size_t)M_PAD * 1024 * 2;
constexpr size_t WS_GRP0 = 42 * MiB;
constexpr size_t WS_END = WS_GRP0 + 6 * GRP_BYTES;
static_assert(WS_AGGB + AGG_BYTES <= WS_GRP0 && WS_END <= 256 * MiB, "d_ws map");
constexpr int G_U = 0, G_GA = 1, G_Q = 2, G_LF = 3, G_V = 4, G_OG = 5;
constexpr size_t OFF_Y = 0, OFF_CONVP = 17825792, OFF_HP = 17850368, OFF_SP = 17858560, OFF_CONVS = 18907136, OFF_HS = 19300352, OFF_SS = 19431424, OUT_FLOATS = 36208640;
constexpr size_t GATE_BYTES = (size_t)M_MAIN * 1024 * 2;
static_assert(2 * GATE_BYTES == OFF_CONVP * 4, "gates fill the y region exactly");
#define N_LAUNCH_MODE 1
namespace pg8 {
#define PG8_LAS __attribute__((address_space(3)))
typedef unsigned short bf16_t;
typedef short bf16x8 __attribute__((ext_vector_type(8)));
typedef float f32x4 __attribute__((ext_vector_type(4)));
typedef unsigned u32x4 __attribute__((ext_vector_type(4)));
constexpr int BM = 256, BK = 64, HALF = 128, HTB = HALF * BK * 2  , STAGE_BYTES = 8 * HTB, NXCD = 8, WGM = 8;

__host__ __device__ __forceinline__ int lds_byte(int r, int c) { const int st = (r >> 4) * 2 + (c >> 5), rr = r & 15, cc = c & 31, ob = rr * 64 + cc * 2; return st * 1024 + (ob ^ (((ob >> 9) & 1) << 5)); }
__host__ __device__ __forceinline__ void stage_rc(int b, int& R, int& C) { const int st = b / 1024, sb = b % 1024, swz = sb ^ (((sb >> 9) & 1) << 5); R = (st >> 1) * 16 + swz / 64; C = (st & 1) * 32 + (swz % 64) / 2; }
__host__ __device__ __forceinline__ int perm32(int rho) { const int n = rho >> 4, i = rho & 15; return 8 * (i >> 2) + 4 * n + (i & 3); }

struct Unit { int pm, pn; };
struct Gemm { const bf16_t* A; const bf16_t* Bt; int M, N, K; };

struct StaticOrder {
    int nM, nN, nwg, G, c;
    __host__ __device__ void init(int M, int N, int G_, int c_) { nM = M / BM; nN = N / BM; nwg = nM * nN; G = G_; c = c_; }
    __host__ __device__ bool next(int i, Unit& u) const {
        const long L = (long)i * G + c; if (L >= nwg) return false;
        int wgid = (int)L; { const int q = nwg / NXCD, r = nwg % NXCD, xcd = wgid % NXCD, off = wgid / NXCD; wgid = (xcd < r ? xcd * (q + 1) : r * (q + 1) + (xcd - r) * q) + off; }
        const int nig = WGM * nN, gid = wgid / nig, fm = gid * WGM, gsz = (nM - fm) < WGM ? (nM - fm) : WGM;
        u.pm = fm + ((wgid % nig) % gsz); u.pn = (wgid % nig) / gsz; return true;
    }
    __device__ __forceinline__ void a_ready(const Unit&) const {}
    __device__ __forceinline__ void done(const Unit&) const {}
};

typedef __bf16 bf16x2n __attribute__((ext_vector_type(2)));
typedef float f32x2n __attribute__((ext_vector_type(2)));
__device__ __forceinline__ unsigned cvt_pk_bf16(float lo, float hi) { const f32x2n v = {lo, hi}; const bf16x2n r = __builtin_convertvector(v, bf16x2n); return __builtin_bit_cast(unsigned, r); }
typedef float f32x2 __attribute__((ext_vector_type(2)));

__device__ __forceinline__ float fsig(float x) { return __builtin_amdgcn_rcpf(1.0f + __expf(-x)); }
__device__ __forceinline__ u32x4 pack8(const f32x4 a, const f32x4 b) { u32x4 w; w.x = cvt_pk_bf16(a[0], a[1]); w.y = cvt_pk_bf16(a[2], a[3]); w.z = cvt_pk_bf16(b[0], b[1]); w.w = cvt_pk_bf16(b[2], b[3]); return w; }
__device__ __forceinline__ float bf_lo(unsigned w) { return __uint_as_float(w << 16); }
__device__ __forceinline__ float bf_hi(unsigned w) { return __uint_as_float(w & 0xffff0000u); }

struct EpiProj {
    static constexpr bool PERM = true, AFTER_DRAIN = false;
    unsigned char* ws; unsigned char* outb; const float* hlb;
    __device__ __forceinline__ void operator()(const f32x4 (&acc)[2][2][4][2], const Unit& u, int wr, int wc, int fr, int fq) const {
        const int grp = u.pn >> 2;
        const int cbase = (u.pn & 3) * 256 + wc * 32 + 8 * fq;
        const int row0 = u.pm * BM + wr * 64 + fr;
        bf16_t* base; int rlim;
        if (grp < 6) { base = (bf16_t*)(ws + WS_GRP0 + (size_t)grp * GRP_BYTES); rlim = M_REAL; } else { base = (bf16_t*)(outb + (size_t)(grp - 6) * GATE_BYTES); rlim = M_MAIN; }
        const int mode = (grp == 0 || grp == 4) ? 0 : (grp == 1) ? 1 : (grp == 2 || grp == 5) ? 2 : (grp == 3) ? 3 : 4;
        float lbv[2][8];
#pragma unroll
        for (int bj = 0; bj < 2; ++bj)
#pragma unroll
            for (int e = 0; e < 8; ++e) lbv[bj][e] = 0.f;
        if (mode == 3) {
#pragma unroll
            for (int bj = 0; bj < 2; ++bj)
#pragma unroll
                for (int e = 0; e < 8; ++e) { const int c = cbase + bj * HALF + e; lbv[bj][e] = __builtin_amdgcn_rcpf(1.0f + __expf(hlb[1024 + c] - hlb[c])); }
        }
#pragma unroll
        for (int ai = 0; ai < 2; ++ai)
#pragma unroll
            for (int m = 0; m < 4; ++m) {
                const int r = row0 + ai * HALF + m * 16;
                if (r < rlim) {
                    bf16_t* rowp = base + (size_t)r * 1024 + cbase;
#pragma unroll
                    for (int bj = 0; bj < 2; ++bj) {
                        f32x4 v0 = acc[ai][bj][m][0], v1 = acc[ai][bj][m][1];
                        if (mode == 1) {
#pragma unroll
                            for (int e = 0; e < 4; ++e) { float x = v0[e]; v0[e] = x * fsig(x * (1.5957691216f + 0.0713548163f * x * x)); x = v1[e]; v1[e] = x * fsig(x * (1.5957691216f + 0.0713548163f * x * x)); }
                        } else if (mode == 2) {
#pragma unroll
                            for (int e = 0; e < 4; ++e) { v0[e] = v0[e] * fsig(v0[e]); v1[e] = v1[e] * fsig(v1[e]); }
                        } else if (mode == 3) {
#pragma unroll
                            for (int e = 0; e < 4; ++e) { const float l0 = lbv[bj][e], l1 = lbv[bj][4 + e]; v0[e] = __logf(l0 + (1.0f - l0) * fsig(v0[e])); v1[e] = __logf(l1 + (1.0f - l1) * fsig(v1[e])); }
                        } else if (mode == 4) {
#pragma unroll
                            for (int e = 0; e < 4; ++e) { v0[e] = fsig(v0[e]); v1[e] = fsig(v1[e]); }
                        }
                        *(u32x4*)(rowp + bj * HALF) = pack8(v0, v1);
                    }
                }
            }
    }
};

template <int WHICH> struct EpiGate {
    static constexpr bool PERM = true, AFTER_DRAIN = false;
    const bf16_t* gate; const bf16_t* prev; bf16_t* out;
    __device__ __forceinline__ void operator()(const f32x4 (&acc)[2][2][4][2], const Unit& u, int wr, int wc, int fr, int fq) const {
        const int cbase = u.pn * BM + wc * 32 + 8 * fq;
        const int row0 = u.pm * BM + wr * 64 + fr;
#pragma unroll
        for (int ai = 0; ai < 2; ++ai)
#pragma unroll
            for (int m = 0; m < 4; ++m) {
                const size_t off = (size_t)(row0 + ai * HALF + m * 16) * 1024 + cbase;
#pragma unroll
                for (int bj = 0; bj < 2; ++bj) {
                    const u32x4 g = *(const u32x4*)(gate + off + bj * HALF);
                    f32x4 v0 = acc[ai][bj][m][0], v1 = acc[ai][bj][m][1];
                    v0[0] *= bf_lo(g.x); v0[1] *= bf_hi(g.x); v0[2] *= bf_lo(g.y); v0[3] *= bf_hi(g.y);
                    v1[0] *= bf_lo(g.z); v1[1] *= bf_hi(g.z); v1[2] *= bf_lo(g.w); v1[3] *= bf_hi(g.w);
                    if (WHICH == 1) {
                        const u32x4 q = *(const u32x4*)(prev + off + bj * HALF);
                        v0[0] += bf_lo(q.x); v0[1] += bf_hi(q.x); v0[2] += bf_lo(q.y); v0[3] += bf_hi(q.y);
                        v1[0] += bf_lo(q.z); v1[1] += bf_hi(q.z); v1[2] += bf_lo(q.w); v1[3] += bf_hi(q.w);
                    }
                    *(u32x4*)(out + off + bj * HALF) = pack8(v0, v1);
                }
            }
    }
};

struct EpiF32 {
    static constexpr bool PERM = true, AFTER_DRAIN = false;
    float* out;
    __device__ __forceinline__ void operator()(const f32x4 (&acc)[2][2][4][2], const Unit& u, int wr, int wc, int fr, int fq) const {
        const int cbase = u.pn * BM + wc * 32 + 8 * fq;
        const int row0 = u.pm * BM + wr * 64 + fr;
#pragma unroll
        for (int ai = 0; ai < 2; ++ai)
#pragma unroll
            for (int m = 0; m < 4; ++m) {
                float* rowp = out + (size_t)(row0 + ai * HALF + m * 16) * 1024 + cbase;
#pragma unroll
                for (int bj = 0; bj < 2; ++bj) { *(f32x4*)(rowp + bj * HALF) = acc[ai][bj][m][0]; *(f32x4*)(rowp + bj * HALF + 4) = acc[ai][bj][m][1]; }
            }
    }
};

struct EpiRelu2 {
    static constexpr bool PERM = true, AFTER_DRAIN = false;
    bf16_t* out;
    __device__ __forceinline__ void operator()(const f32x4 (&acc)[2][2][4][2], const Unit& u, int wr, int wc, int fr, int fq) const {
        const int cbase = u.pn * BM + wc * 32 + 8 * fq;
        const int row0 = u.pm * BM + wr * 64 + fr;
#pragma unroll
        for (int ai = 0; ai < 2; ++ai)
#pragma unroll
            for (int m = 0; m < 4; ++m) {
                bf16_t* rowp = out + (size_t)(row0 + ai * HALF + m * 16) * 4096 + cbase;
#pragma unroll
                for (int bj = 0; bj < 2; ++bj) {
                    f32x4 v0 = acc[ai][bj][m][0], v1 = acc[ai][bj][m][1];
#pragma unroll
                    for (int e = 0; e < 4; ++e) { const float a = fmaxf(v0[e], 0.f), b = fmaxf(v1[e], 0.f); v0[e] = a * a; v1[e] = b * b; }
                    *(u32x4*)(rowp + bj * HALF) = pack8(v0, v1);
                }
            }
    }
};

template <class Epi, class Sched, bool ALIGN_EPI = false, bool SP2 = false>
__device__ __forceinline__ void gemm_phase(PG8_LAS unsigned char* lds, const Gemm g, const Sched& S, const Epi& E) {
    const int tid = threadIdx.x, wid = __builtin_amdgcn_readfirstlane(tid >> 6), lane = tid & 63, wr = wid >> 2, wc = wid & 3, fr = lane & 15, fq = lane >> 4;
    const int K = g.K, nt = K / BK;
    unsigned voffA[2], voffB[2];
#pragma unroll
    for (int i = 0; i < 2; ++i) { int R, C; stage_rc(tid * 16 + i * 8192, R, C); const int Rb = Epi::PERM ? ((R & ~31) + perm32(R & 31)) : R;
        voffA[i] = (unsigned)(R * K + C) * 2u; voffB[i] = (unsigned)(Rb * K + C) * 2u; }
    const size_t kstep = (size_t)(BK * 2);
    const size_t hstep = (size_t)HALF * K * 2;
    const size_t tstep = 2 * hstep;
    const unsigned ldsw = (unsigned)wid * 1024u;
    const int aoff = lds_byte(wr * 64 + fr, fq * 8), boff = lds_byte(wc * 32 + fr, fq * 8);
#define PG8_SA(b, h) (((b) * 2 + (h)) * HTB)
#define PG8_SB(b, h) ((4 + (b) * 2 + (h)) * HTB)
#define PG8_STAGE(bufoff, gbase, voff) do { _Pragma("unroll") for (int _i = 0; _i < 2; ++_i) \
        __builtin_amdgcn_global_load_lds((const unsigned*)((const char*)(gbase) + (voff)[_i]), (PG8_LAS unsigned*)(lds + (bufoff) + ldsw + _i * 8192), 16, 0, 0); } while (0)
#define PG8_LDA(dst, b, h) do { _Pragma("unroll") for (int m = 0; m < 4; ++m) _Pragma("unroll") for (int k = 0; k < 2; ++k) dst[m][k] = *(const PG8_LAS bf16x8*)(lds + PG8_SA(b, h) + aoff + m * 2048 + k * 1024); } while (0)
#define PG8_LDB(dst, b, h) do { _Pragma("unroll") for (int n = 0; n < 2; ++n) _Pragma("unroll") for (int k = 0; k < 2; ++k) dst[n][k] = *(const PG8_LAS bf16x8*)(lds + PG8_SB(b, h) + boff + n * 2048 + k * 1024); } while (0)
#define PG8_MMA(ai, bj, At, Bt) do { __builtin_amdgcn_s_setprio(1); _Pragma("unroll") for (int m = 0; m < 4; ++m) _Pragma("unroll") for (int n = 0; n < 2; ++n) _Pragma("unroll") for (int k = 0; k < 2; ++k) \
        acc[ai][bj][m][n] = __builtin_amdgcn_mfma_f32_16x16x32_bf16(Bt[n][k], At[m][k], acc[ai][bj][m][n], 0, 0, 0); __builtin_amdgcn_s_setprio(0); } while (0)
#define PG8_WAIT_V(n) asm volatile("s_waitcnt vmcnt(" #n ")" ::: "memory")
#define PG8_WAIT_L(n) asm volatile("s_waitcnt lgkmcnt(" #n ")" ::: "memory")
#define PG8_BAR __builtin_amdgcn_s_barrier()
#define PG8_SCHED __builtin_amdgcn_sched_barrier(0)
    Unit cur, nxt; int ui = 0;
    if (!S.next(0, cur)) return;
    f32x4 acc[2][2][4][2];
#pragma unroll
    for (int a = 0; a < 2; ++a)
#pragma unroll
        for (int b = 0; b < 2; ++b)
#pragma unroll
            for (int m = 0; m < 4; ++m)
#pragma unroll
                for (int n = 0; n < 2; ++n) acc[a][b][m][n] = (f32x4){0.f, 0.f, 0.f, 0.f};
    bf16x8 At[4][2], B0[2][2], B1[2][2];
    const char* cA = (const char*)g.A + (size_t)cur.pm * tstep; const char* cB = (const char*)g.Bt + (size_t)cur.pn * tstep;
    S.a_ready(cur);
    if constexpr (SP2) {
        PG8_STAGE(PG8_SB(0, 0), cB, voffB); PG8_STAGE(PG8_SB(0, 1), cB + hstep, voffB); PG8_STAGE(PG8_SA(0, 0), cA, voffA); PG8_STAGE(PG8_SA(0, 1), cA + hstep, voffA);
        if (wr == 1) PG8_BAR;
        PG8_WAIT_V(2); PG8_BAR;
        PG8_STAGE(PG8_SB(1, 0), cB + kstep, voffB); PG8_STAGE(PG8_SA(1, 0), cA + kstep, voffA); PG8_STAGE(PG8_SB(1, 1), cB + hstep + kstep, voffB);
        PG8_WAIT_V(6); PG8_BAR;
    } else {
        PG8_STAGE(PG8_SB(0, 0), cB, voffB); PG8_STAGE(PG8_SA(0, 0), cA, voffA); PG8_STAGE(PG8_SB(0, 1), cB + hstep, voffB); PG8_STAGE(PG8_SA(0, 1), cA + hstep, voffA);
        if (wr == 1) PG8_BAR;
        PG8_WAIT_V(4); PG8_BAR;
        PG8_STAGE(PG8_SB(1, 0), cB + kstep, voffB); PG8_STAGE(PG8_SA(1, 0), cA + kstep, voffA); PG8_STAGE(PG8_SB(1, 1), cB + hstep + kstep, voffB);
        PG8_WAIT_V(6); PG8_BAR;
    }
    for (;;) {
        const bool has_next = S.next(ui + 1, nxt);
        const char* nA = has_next ? (const char*)g.A + (size_t)nxt.pm * tstep : cA; const char* nB = has_next ? (const char*)g.Bt + (size_t)nxt.pn * tstep : cB;
        for (int t = 0; t < nt; t += 2) {
            const bool last = (t == nt - 2);
            const char* a1 = cA + (size_t)(t + 1) * kstep;
            const char* a2 = last ? nA : cA + (size_t)(t + 2) * kstep; const char* b2 = last ? nB : cB + (size_t)(t + 2) * kstep;
            const char* a3 = a2 + kstep; const char* b3 = b2 + kstep;
            if (last && has_next) S.a_ready(nxt);
            if constexpr (SP2) {
            PG8_LDB(B0, 0, 0); PG8_LDB(B1, 0, 1); PG8_SCHED; PG8_LDA(At, 0, 0); PG8_STAGE(PG8_SA(1, 1), a1 + hstep, voffA);
            PG8_WAIT_V(8); PG8_WAIT_L(0); PG8_BAR; PG8_MMA(0, 0, At, B0); PG8_MMA(0, 1, At, B1); PG8_BAR; PG8_SCHED;
            PG8_LDA(At, 0, 1); PG8_STAGE(PG8_SB(0, 0), b2, voffB); PG8_STAGE(PG8_SB(0, 1), b2 + hstep, voffB); PG8_STAGE(PG8_SA(0, 0), a2, voffA);
            PG8_WAIT_V(8); PG8_WAIT_L(0); PG8_BAR; PG8_MMA(1, 0, At, B0); PG8_MMA(1, 1, At, B1); PG8_BAR; PG8_SCHED;
            PG8_LDB(B0, 1, 0); PG8_LDB(B1, 1, 1); PG8_SCHED; PG8_LDA(At, 1, 0); PG8_STAGE(PG8_SA(0, 1), a2 + hstep, voffA);
            PG8_WAIT_V(8); PG8_WAIT_L(0); PG8_BAR; PG8_MMA(0, 0, At, B0); PG8_MMA(0, 1, At, B1); PG8_BAR; PG8_SCHED;
            PG8_LDA(At, 1, 1); PG8_STAGE(PG8_SB(1, 0), b3, voffB); PG8_STAGE(PG8_SB(1, 1), b3 + hstep, voffB); PG8_STAGE(PG8_SA(1, 0), a3, voffA);
            PG8_WAIT_V(8); PG8_WAIT_L(0); PG8_BAR; PG8_MMA(1, 0, At, B0); PG8_MMA(1, 1, At, B1); PG8_BAR; PG8_SCHED;
            } else {
            PG8_LDB(B0, 0, 0); PG8_SCHED; PG8_LDA(At, 0, 0); PG8_STAGE(PG8_SA(1, 1), a1 + hstep, voffA);
            PG8_WAIT_L(8); PG8_BAR; PG8_WAIT_L(0); PG8_MMA(0, 0, At, B0); PG8_BAR; PG8_SCHED;
            PG8_LDB(B1, 0, 1); PG8_STAGE(PG8_SB(0, 0), b2, voffB);
            PG8_BAR; PG8_WAIT_L(0); PG8_MMA(0, 1, At, B1); PG8_BAR;
            PG8_LDA(At, 0, 1); PG8_STAGE(PG8_SA(0, 0), a2, voffA);
            PG8_BAR; PG8_WAIT_L(0); PG8_MMA(1, 0, At, B0); PG8_BAR; PG8_SCHED;
            PG8_STAGE(PG8_SB(0, 1), b2 + hstep, voffB);
            PG8_WAIT_V(6); PG8_BAR; PG8_MMA(1, 1, At, B1); PG8_BAR;
            PG8_LDB(B0, 1, 0); PG8_SCHED; PG8_LDA(At, 1, 0); PG8_STAGE(PG8_SA(0, 1), a2 + hstep, voffA);
            PG8_WAIT_L(8); PG8_BAR; PG8_WAIT_L(0); PG8_MMA(0, 0, At, B0); PG8_BAR; PG8_SCHED;
            PG8_LDB(B1, 1, 1); PG8_STAGE(PG8_SB(1, 0), b3, voffB);
            PG8_BAR; PG8_WAIT_L(0); PG8_MMA(0, 1, At, B1); PG8_BAR;
            PG8_LDA(At, 1, 1); PG8_STAGE(PG8_SA(1, 0), a3, voffA);
            PG8_BAR; PG8_WAIT_L(0); PG8_MMA(1, 0, At, B0); PG8_BAR; PG8_SCHED;
            PG8_STAGE(PG8_SB(1, 1), b3 + hstep, voffB);
            PG8_WAIT_V(6); PG8_BAR; PG8_MMA(1, 1, At, B1); PG8_BAR;
            }
        }
        if constexpr (ALIGN_EPI) { if (wr == 0) PG8_BAR; }
        if constexpr (!Epi::AFTER_DRAIN) { E(acc, cur, wr, wc, fr, fq); S.done(cur); }
        if (!has_next) break;
#pragma unroll
        for (int a = 0; a < 2; ++a)
#pragma unroll
            for (int b = 0; b < 2; ++b)
#pragma unroll
                for (int m = 0; m < 4; ++m)
#pragma unroll
                    for (int n = 0; n < 2; ++n) acc[a][b][m][n] = (f32x4){0.f, 0.f, 0.f, 0.f};
        cur = nxt; cA = nA; cB = nB; ++ui;
        if constexpr (ALIGN_EPI) { if (wr == 1) PG8_BAR; }
    }
    PG8_WAIT_V(0);
    if constexpr (!ALIGN_EPI) { if (wr == 0) PG8_BAR; }
    PG8_BAR;
    if constexpr (Epi::AFTER_DRAIN) { E.fused(acc, cur, wr, wc, fr, fq, lds, wid, lane); S.done(cur); }
#undef PG8_SA
#undef PG8_SB
#undef PG8_STAGE
#undef PG8_LDA
#undef PG8_LDB
#undef PG8_MMA
#undef PG8_WAIT_V
#undef PG8_WAIT_L
#undef PG8_BAR
#undef PG8_SCHED
}
}

#define LAS __attribute__((address_space(3)))
typedef unsigned short bf16_t;
typedef short bf16x8 __attribute__((ext_vector_type(8)));
typedef float f32x4 __attribute__((ext_vector_type(4)));
typedef unsigned u32x4 __attribute__((ext_vector_type(4)));
typedef unsigned u32x2 __attribute__((ext_vector_type(2)));
constexpr int NWAVES = 8, NTHREADS = 512;
constexpr int LDS_BYTES = 147456;
constexpr int NPHASES = 12;

struct Params {
    const float *x_prompt, *x_sample, *state_conv, *state_rglru, *state_hgrn, *meta, *gains, *w_in, *conv_w, *conv_b, *rg_w, *rg_b, *ig_w, *ig_b, *lam, *hgrn_lb, *gnorm, *w_a, *w_b, *w_out, *w_up, *w_down;
    float* out; unsigned char* ws;
    int ph_lo, ph_hi, use_bar, pad;
};

using pg8::cvt_pk_bf16;
__device__ __forceinline__ float bflo(unsigned w) { return __uint_as_float(w << 16); }
__device__ __forceinline__ float bfhi(unsigned w) { return __uint_as_float(w & 0xffff0000u); }
__device__ __forceinline__ float bf2f(bf16_t h) { return __uint_as_float((unsigned)h << 16); }
__device__ __forceinline__ bf16_t f2bf(float f) { return (bf16_t)(cvt_pk_bf16(f, 0.f) & 0xffffu); }
__device__ __forceinline__ float fsig(float x) { return __builtin_amdgcn_rcpf(1.0f + __expf(-x)); }
__device__ __forceinline__ float wave_sum(float v) {
#pragma unroll
    for (int o = 1; o < 64; o <<= 1) v += __shfl_xor(v, o);
    return v;
}
__device__ __forceinline__ f32x4 mfma16(bf16x8 first, bf16x8 second, f32x4 c) { return __builtin_amdgcn_mfma_f32_16x16x32_bf16(first, second, c, 0, 0, 0); }

#define XB_TMO      128
#define XB_XCNT(j)  (256  + 64 * (j))
#define XB_XSUB(j)  (1280 + 64 * (j))
#define XB_XGEN(j)  (2304 + 64 * (j))
#define XB_TOP      3328
#define XB_TOPGEN   3392
#define XCD_BAR_WORDS 3456
#define XB_SPIN_CAP (1u << 18)

__device__ __forceinline__ unsigned xb_ld(unsigned* p)              { return __hip_atomic_load(p, __ATOMIC_RELAXED, __HIP_MEMORY_SCOPE_AGENT); }
__device__ __forceinline__ unsigned xb_add(unsigned* p, unsigned v) { return __hip_atomic_fetch_add(p, v, __ATOMIC_RELAXED, __HIP_MEMORY_SCOPE_AGENT); }
__device__ __forceinline__ unsigned xb_xcc_id() { return (unsigned)__builtin_amdgcn_s_getreg((3 << 11) | 20) & 0xFu; }
#define XB_SPIN(cond, bar) do { unsigned _sp = 0; while (cond) { __builtin_amdgcn_s_sleep(1); \
    if ((++_sp & 255u) == 0u) { if (xb_ld(&(bar)[XB_TMO])) break; if (_sp > XB_SPIN_CAP) { atomicAdd(&(bar)[XB_TMO], 1u); break; } } } } while (0)

struct XcdBarrier {
    unsigned* bar; unsigned x;
    volatile LAS unsigned* st;
};

__device__ __forceinline__ XcdBarrier xcd_barrier_post(unsigned* bar, volatile LAS unsigned* st) {
    XcdBarrier b; b.bar = bar; b.x = xb_xcc_id(); b.st = st;
    if (threadIdx.x == 0) (void)xb_add(&bar[XB_XCNT(b.x)], 1u);
    return b;
}
__device__ __forceinline__ void xcd_barrier_complete(unsigned* bar, unsigned x, unsigned& nloc, unsigned& nx) {
    const unsigned G = gridDim.x * gridDim.y * gridDim.z;
    unsigned sum, cnt, mine, sp = 0u;
    for (;;) {
        sum = 0u; cnt = 0u; mine = 0u;
#pragma unroll
        for (unsigned j = 0; j < 16; ++j) { const unsigned c = xb_ld(&bar[XB_XCNT(j)]); sum += c; cnt += (c > 0u) ? 1u : 0u; mine = (j == x) ? c : mine; }
        if (sum == G) break;
        __builtin_amdgcn_s_sleep(1);
        if ((++sp & 255u) == 0u) { if (xb_ld(&bar[XB_TMO])) break; if (sp > XB_SPIN_CAP) { atomicAdd(&bar[XB_TMO], 1u); break; } }
    }
    nloc = mine > 0u ? mine : 1u; nx = cnt > 0u ? cnt : 1u;
}

__device__ __forceinline__ void xcd_barrier(const XcdBarrier& b) {
    asm volatile("s_waitcnt vmcnt(0)" ::: "memory");
    __syncthreads();
    if (threadIdx.x == 0) {
        unsigned* bar = b.bar;
        __builtin_amdgcn_s_waitcnt(0);
        unsigned nloc = b.st[0], nx = b.st[1];
        if (nloc == 0u) { xcd_barrier_complete(bar, b.x, nloc, nx); b.st[0] = nloc; b.st[1] = nx; }
        const unsigned old = xb_add(&bar[XB_XSUB(b.x)], 1u);
        const unsigned gen = old / nloc;
        if (old + 1u == (gen + 1u) * nloc) {
            __builtin_amdgcn_fence(__ATOMIC_RELEASE, "agent");
            asm volatile("s_waitcnt vmcnt(0)" ::: "memory");
            const unsigned og = xb_add(&bar[XB_TOP], 1u);
            const unsigned tg = og / nx;
            if (og + 1u == (tg + 1u) * nx) xb_add(&bar[XB_TOPGEN], 1u);
            else XB_SPIN(xb_ld(&bar[XB_TOPGEN]) == tg, bar);
            __builtin_amdgcn_fence(__ATOMIC_ACQUIRE, "agent");
            xb_add(&bar[XB_XGEN(b.x)], 1u);
            asm volatile("s_waitcnt vmcnt(0)" ::: "memory");
        } else {
            XB_SPIN(xb_ld(&bar[XB_XGEN(b.x)]) == gen, bar);
            __builtin_amdgcn_fence(__ATOMIC_ACQUIRE, "agent");
            asm volatile("s_waitcnt vmcnt(0)" ::: "memory");
        }
    }
    __syncthreads();
}


__device__ __forceinline__ void p0_transpose_item(const float* W, int K, int N, bf16_t* WT, int row_off, LAS float* scr, int item, int lane) {
    const int nblk = N / 32, kb = item / nblk, nb = item % nblk, k0 = 64 * kb, n0 = 32 * nb;
#pragma unroll 8
    for (int i = 0; i < 32; ++i) { const int kk = 2 * i + (lane >> 5); scr[kk * 33 + (lane & 31)] = W[(size_t)(k0 + kk) * N + n0 + (lane & 31)]; }
    asm volatile("s_waitcnt lgkmcnt(0)" ::: "memory");
    const int c = lane & 7;
#pragma unroll
    for (int j = 0; j < 4; ++j) { const int n = (lane >> 3) + 8 * j; const LAS float* s = scr + (8 * c) * 33 + n;
        u32x4 o; o.x = cvt_pk_bf16(s[0 * 33], s[1 * 33]); o.y = cvt_pk_bf16(s[2 * 33], s[3 * 33]); o.z = cvt_pk_bf16(s[4 * 33], s[5 * 33]); o.w = cvt_pk_bf16(s[6 * 33], s[7 * 33]);
        *(u32x4*)(WT + (size_t)(row_off + n0 + n) * K + k0 + 8 * c) = o; }
    asm volatile("s_waitcnt lgkmcnt(0)" ::: "memory");
}
__device__ __forceinline__ void rms_row_to_bf16(const float* xrow, const float* g, bf16_t* orow, int lane) {
    const f32x4* xr = (const f32x4*)xrow + lane; const f32x4* gr = (const f32x4*)g + lane;
    f32x4 v[4]; float s = 0.f;
#pragma unroll
    for (int j = 0; j < 4; ++j) { v[j] = xr[64 * j]; s += (v[j].x * v[j].x + v[j].y * v[j].y) + (v[j].z * v[j].z + v[j].w * v[j].w); }
    const float rstd = 1.0f / sqrtf(wave_sum(s) * (1.f / D) + EPS);
    u32x2* o8 = (u32x2*)orow + lane;
#pragma unroll
    for (int j = 0; j < 4; ++j) { const f32x4 gg = gr[64 * j]; u32x2 w; w.x = cvt_pk_bf16(v[j].x * rstd * gg.x, v[j].y * rstd * gg.y); w.y = cvt_pk_bf16(v[j].z * rstd * gg.z, v[j].w * rstd * gg.w); o8[64 * j] = w; }
}
__device__ __forceinline__ void p0_prologue(const Params& p, LAS unsigned char* lds) {
    const int tid = threadIdx.x, lane = tid & 63, wave = __builtin_amdgcn_readfirstlane(tid >> 6);
    LAS float* scr = (LAS float*)(lds + wave * 16384);
    const int gw = blockIdx.x * NWAVES + wave, NGW = gridDim.x * NWAVES;
    constexpr int I_IN = (D / 64) * (DIN / 32), I_UP = (D / 64) * (DFF / 32), I_DN = (DFF / 64) * (D / 32), I_SQ = (D / 64) * (D / 32), I_RG = 8;
    constexpr int NITEMS = I_IN + I_UP + I_DN + 3 * I_SQ + 16 * I_RG;
    unsigned char* ws = p.ws;
    for (int it = gw; it < NITEMS; it += NGW) {
        int r = it;
        if (r < I_IN) { p0_transpose_item(p.w_in, D, DIN, (bf16_t*)(ws + WS_WIN), 0, scr, r, lane); continue; } r -= I_IN;
        if (r < I_UP) { p0_transpose_item(p.w_up, D, DFF, (bf16_t*)(ws + WS_WUP), 0, scr, r, lane); continue; } r -= I_UP;
        if (r < I_DN) { p0_transpose_item(p.w_down, DFF, D, (bf16_t*)(ws + WS_WDN), 0, scr, r, lane); continue; } r -= I_DN;
        if (r < I_SQ) { p0_transpose_item(p.w_a, D, D, (bf16_t*)(ws + WS_WA), 0, scr, r, lane); continue; } r -= I_SQ;
        if (r < I_SQ) { p0_transpose_item(p.w_b, D, D, (bf16_t*)(ws + WS_WB), 0, scr, r, lane); continue; } r -= I_SQ;
        if (r < I_SQ) { p0_transpose_item(p.w_out, D, D, (bf16_t*)(ws + WS_WOUT), 0, scr, r, lane); continue; } r -= I_SQ;
        { const int hm = r / I_RG, ii = r % I_RG, h = hm >> 1, which = hm & 1;
          p0_transpose_item((which ? p.ig_w : p.rg_w) + (size_t)h * 128 * 128, 128, 128, (bf16_t*)(ws + WS_WRG), h * 256 + which * 128, scr, ii, lane); }
    }
    bf16_t* XN = (bf16_t*)((unsigned char*)p.out + OFF_SS * 4);
    for (int m = gw; m < M_PAD; m += NGW) {
        bf16_t* orow = XN + (size_t)m * D;
        if (m < M_REAL) {
            const float* xrow = m < ROW_SAMPLE ? p.x_prompt + (size_t)m * D : m < M_MAIN ? p.x_sample + (size_t)(m - ROW_SAMPLE) * D : p.meta + (size_t)(m - ROW_META) * D;
            rms_row_to_bf16(xrow, p.gains, orow, lane);
        } else {
            u32x2* o8 = (u32x2*)orow + lane;
#pragma unroll
            for (int j = 0; j < 4; ++j) o8[64 * j] = (u32x2){0u, 0u};
        }
    }
}

__device__ __forceinline__ float softplus_neg(float lam) {
    const float x = __expf(-lam);
    return x < 0.03f ? x * (1.0f - x * (0.5f - x * (1.0f / 3.0f - 0.25f * x))) : __logf(1.0f + x);
}
__device__ __forceinline__ float neg_expm1(float y) {
    if (y > -0.3f) { float q = 1.0f / 5040.0f; q = q * y + 1.0f / 720.0f; q = q * y + 1.0f / 120.0f; q = q * y + 1.0f / 24.0f; q = q * y + 1.0f / 6.0f; q = q * y + 0.5f; q = q * y + 1.0f; return -y * q; }
    return 1.0f - __expf(y);
}
constexpr int RG_WB = 0, RG_UCB = 69632, RG_UCF = 87040;
__device__ __forceinline__ void rg_phase(const Params& p, LAS unsigned char* lds, int mode, int wg, int nwg) {
    const int tid = threadIdx.x, lane = tid & 63, w = __builtin_amdgcn_readfirstlane(tid >> 6), fr = lane & 15, fq = lane >> 4;
    const int h = wg & 7, idx = wg >> 3, nidx = nwg >> 3;
    unsigned char* ws = p.ws;
    const bf16_t* U = (const bf16_t*)(ws + WS_GRP0 + G_U * GRP_BYTES);
    bf16_t* GA = (bf16_t*)(ws + WS_GRP0 + G_GA * GRP_BYTES);
    float* AGGA = (float*)(ws + WS_AGGA); float* AGGB = (float*)(ws + WS_AGGB);
    LAS unsigned char* WB = lds + RG_WB; LAS unsigned char* UCB = lds + RG_UCB; LAS float* UCF = (LAS float*)(lds + RG_UCF);
    __syncthreads();
    {   const bf16_t* wsrc = (const bf16_t*)(ws + WS_WRG) + (size_t)h * 256 * 128;
#pragma unroll
        for (int it = 0; it < 8; ++it) { const int row = (tid >> 4) + 32 * it, ch = tid & 15; *(LAS u32x4*)(WB + row * 272 + ch * 16) = *(const u32x4*)(wsrc + row * 128 + ch * 8); }
    }
    __syncthreads();
    bf16x8 bw[2][4];
#pragma unroll
    for (int nt = 0; nt < 2; ++nt)
#pragma unroll
        for (int ks = 0; ks < 4; ++ks) bw[nt][ks] = *(const LAS bf16x8*)(WB + (nt * 128 + 16 * w + fr) * 272 + 64 * ks + 16 * fq);
    const int c0 = h * 128 + 16 * w + 4 * fq;
    const f32x4 rgb = *(const f32x4*)(p.rg_b + c0), igb = *(const f32x4*)(p.ig_b + c0), lam4 = *(const f32x4*)(p.lam + c0);
    f32x4 sp8;
#pragma unroll
    for (int i = 0; i < 4; ++i) sp8[i] = 8.0f * softplus_neg(lam4[i]);
    const int nunits = mode == 0 ? NB * 33 + 16 : NB * 32;
    const int crow = tid >> 3, cgp = tid & 7, ch0 = h * 128 + 16 * cgp;
    for (int ui = idx; ui < nunits; ui += nidx) {
        int b = 0, j = 0, st = 0; bool sample = false, full = true;
        if (mode == 0) { if (ui < NB * 33) { b = ui / 33; j = ui % 33; full = false; } else { sample = true; st = ui - NB * 33; } }
        else { b = ui >> 5; j = (ui & 31) + 1; }
        {
            float uc[16];
            {   const f32x4* cb = (const f32x4*)(p.conv_b + ch0);
#pragma unroll
                for (int q = 0; q < 4; ++q) { const f32x4 v = cb[q]; uc[4 * q] = v.x; uc[4 * q + 1] = v.y; uc[4 * q + 2] = v.z; uc[4 * q + 3] = v.w; } }
            const bool rowvalid = sample || j > 0 || crow < 16;
#pragma unroll
            for (int k = 0; k < 4; ++k) {
                const bf16_t* src = nullptr; const float* srcf = nullptr;
                if (sample) { const int seg = crow >> 3, t = crow & 7, db = 8 * st + seg, ts = t + k - 3;
                    if (ts >= 0) src = U + (size_t)(ROW_SAMPLE + db * 8 + ts) * 1024 + ch0; else srcf = p.state_conv + ((size_t)db * 3 + ts + 3) * 1024 + ch0; }
                else { const int pp = (j == 0 ? crow : 16 + 64 * (j - 1) + crow) + k - 3;
                    if (rowvalid && pp >= 0) { const size_t grow = pp < 16 ? (size_t)(ROW_META + pp) : (size_t)b * 2048 + pp - 16; src = U + grow * 1024 + ch0; } }
                float val[16];
                if (src) { const u32x4 a = ((const u32x4*)src)[0], b2 = ((const u32x4*)src)[1];
                    val[0] = bflo(a.x); val[1] = bfhi(a.x); val[2] = bflo(a.y); val[3] = bfhi(a.y); val[4] = bflo(a.z); val[5] = bfhi(a.z); val[6] = bflo(a.w); val[7] = bfhi(a.w);
                    val[8] = bflo(b2.x); val[9] = bfhi(b2.x); val[10] = bflo(b2.y); val[11] = bfhi(b2.y); val[12] = bflo(b2.z); val[13] = bfhi(b2.z); val[14] = bflo(b2.w); val[15] = bfhi(b2.w); }
                else if (srcf) {
#pragma unroll
                    for (int q = 0; q < 4; ++q) { const f32x4 v = ((const f32x4*)srcf)[q]; val[4 * q] = v.x; val[4 * q + 1] = v.y; val[4 * q + 2] = v.z; val[4 * q + 3] = v.w; } }
                else {
#pragma unroll
                    for (int e = 0; e < 16; ++e) val[e] = 0.f; }
                const f32x4* cw = (const f32x4*)(p.conv_w + (size_t)k * 1024 + ch0);
#pragma unroll
                for (int q = 0; q < 4; ++q) { const f32x4 wv = cw[q]; uc[4 * q] += wv.x * val[4 * q]; uc[4 * q + 1] += wv.y * val[4 * q + 1]; uc[4 * q + 2] += wv.z * val[4 * q + 2]; uc[4 * q + 3] += wv.w * val[4 * q + 3]; }
            }
            if (!rowvalid) {
#pragma unroll
                for (int e = 0; e < 16; ++e) uc[e] = 0.f; }
#pragma unroll
            for (int q = 0; q < 4; ++q) *(LAS f32x4*)(UCF + crow * 132 + 16 * cgp + 4 * q) = (f32x4){uc[4 * q], uc[4 * q + 1], uc[4 * q + 2], uc[4 * q + 3]};
            u32x4 o0, o1;
            o0.x = cvt_pk_bf16(uc[0], uc[1]); o0.y = cvt_pk_bf16(uc[2], uc[3]); o0.z = cvt_pk_bf16(uc[4], uc[5]); o0.w = cvt_pk_bf16(uc[6], uc[7]);
            o1.x = cvt_pk_bf16(uc[8], uc[9]); o1.y = cvt_pk_bf16(uc[10], uc[11]); o1.z = cvt_pk_bf16(uc[12], uc[13]); o1.w = cvt_pk_bf16(uc[14], uc[15]);
            *(LAS u32x4*)(UCB + crow * 272 + 32 * cgp) = o0; *(LAS u32x4*)(UCB + crow * 272 + 32 * cgp + 16) = o1;
        }
        __syncthreads();
        f32x4 accr[4], acci[4];
#pragma unroll
        for (int m = 0; m < 4; ++m) { accr[m] = (f32x4){0.f, 0.f, 0.f, 0.f}; acci[m] = (f32x4){0.f, 0.f, 0.f, 0.f}; }
#pragma unroll
        for (int m = 0; m < 4; ++m)
#pragma unroll
            for (int ks = 0; ks < 4; ++ks) { const bf16x8 af = *(const LAS bf16x8*)(UCB + (16 * m + fr) * 272 + 64 * ks + 16 * fq);
                accr[m] = mfma16(bw[0][ks], af, accr[m]); acci[m] = mfma16(bw[1][ks], af, acci[m]); }
        float a[4][4], bb[4][4];
#pragma unroll
        for (int m = 0; m < 4; ++m) {
            const int row = 16 * m + fr;
            const f32x4 ucv = *(const LAS f32x4*)(UCF + row * 132 + 16 * w + 4 * fq);
            const bool valid = sample || j > 0 || row < 16;
            const bool first = !sample && j == 0 && row == 0;
#pragma unroll
            for (int i = 0; i < 4; ++i) {
                const float r = fsig(accr[m][i] + rgb[i]), ig = fsig(acci[m][i] + igb[i]);
                const float la = -r * sp8[i];
                const float av = __expf(la);
                float mult = sqrtf(neg_expm1(2.0f * la));
                if (first) mult = 1.0f;
                a[m][i] = valid ? av : 1.0f; bb[m][i] = valid ? mult * ig * ucv[i] : 0.0f;
            }
        }
        if (!sample) {
#pragma unroll
            for (int m = 0; m < 4; ++m)
#pragma unroll
                for (int i = 0; i < 4; ++i)
#pragma unroll
                    for (int d = 1; d < 16; d <<= 1) { const float ap = __shfl_up(a[m][i], d, 16), bp = __shfl_up(bb[m][i], d, 16); if (fr >= d) { bb[m][i] = a[m][i] * bp + bb[m][i]; a[m][i] = a[m][i] * ap; } }
            float ca[4] = {1.f, 1.f, 1.f, 1.f}, cb[4] = {0.f, 0.f, 0.f, 0.f};
#pragma unroll
            for (int m = 0; m < 4; ++m)
#pragma unroll
                for (int i = 0; i < 4; ++i) { bb[m][i] = a[m][i] * cb[i] + bb[m][i]; a[m][i] = a[m][i] * ca[i]; ca[i] = __shfl(a[m][i], 15, 16); cb[i] = __shfl(bb[m][i], 15, 16); }
        } else {
#pragma unroll
            for (int m = 0; m < 4; ++m)
#pragma unroll
                for (int i = 0; i < 4; ++i)
#pragma unroll
                    for (int d = 1; d < 8; d <<= 1) { const float ap = __shfl_up(a[m][i], d, 8), bp = __shfl_up(bb[m][i], d, 8); if ((fr & 7) >= d) { bb[m][i] = a[m][i] * bp + bb[m][i]; a[m][i] = a[m][i] * ap; } }
        }
        if (!full) {
            if (fr == 15) { const size_t o = ((size_t)b * 33 + j) * 1024 + c0;
                *(f32x4*)(AGGA + o) = (f32x4){a[3][0], a[3][1], a[3][2], a[3][3]}; *(f32x4*)(AGGB + o) = (f32x4){bb[3][0], bb[3][1], bb[3][2], bb[3][3]}; }
        } else {
            f32x4 hin = (f32x4){0.f, 0.f, 0.f, 0.f};
            if (!sample) { for (int jj = 0; jj < j; ++jj) { const size_t o = ((size_t)b * 33 + jj) * 1024 + c0; const f32x4 A4 = *(const f32x4*)(AGGA + o), B4 = *(const f32x4*)(AGGB + o); hin = A4 * hin + B4; } }
#pragma unroll
            for (int m = 0; m < 4; ++m) {
                const int row = 16 * m + fr;
                size_t grow;
                if (sample) { const int db = 8 * st + (row >> 3); hin = *(const f32x4*)(p.state_rglru + (size_t)db * 1024 + c0); grow = (size_t)ROW_SAMPLE + 64 * st + row; }
                else grow = (size_t)b * 2048 + 64 * (j - 1) + row;
                f32x4 hv;
#pragma unroll
                for (int i = 0; i < 4; ++i) hv[i] = a[m][i] * hin[i] + bb[m][i];
                bf16_t* gp = GA + grow * 1024 + c0;
                const u32x2 g = *(const u32x2*)gp;
                u32x2 y; y.x = cvt_pk_bf16(hv[0] * bflo(g.x), hv[1] * bfhi(g.x)); y.y = cvt_pk_bf16(hv[2] * bflo(g.y), hv[3] * bfhi(g.y));
                *(u32x2*)gp = y;
                if (sample) { if ((fr & 7) == 7) { const int db = 8 * st + (row >> 3); *(f32x4*)(p.out + OFF_HS + (size_t)db * 1024 + c0) = hv; } }
                else if (j == 32 && m == 3 && fr == 15) *(f32x4*)(p.out + OFF_HP + (size_t)b * 1024 + c0) = hv;
            }
        }
        __syncthreads();
    }
}

__device__ __forceinline__ void hgrn_sample_item(const Params& p, LAS unsigned char* lds, int db, int h) {
    const int tid = threadIdx.x;
    unsigned char* ws = p.ws;
    const bf16_t* Qb = (const bf16_t*)(ws + WS_GRP0 + G_Q * GRP_BYTES); const bf16_t* LFb = (const bf16_t*)(ws + WS_GRP0 + G_LF * GRP_BYTES);
    bf16_t* Vb = (bf16_t*)(ws + WS_GRP0 + G_V * GRP_BYTES);
    LAS float* FF = (LAS float*)lds; LAS float* KK = FF + 1024; LAS float* QQ = KK + 1024; LAS float* VV = QQ + 1024; LAS float* ORED = VV + 1024;
    const size_t row0 = (size_t)ROW_SAMPLE + db * 8;
    {   const int k = tid & 127, tq = tid >> 7;
#pragma unroll
        for (int tt = 0; tt < 2; ++tt) { const int t = 2 * tq + tt; const size_t off = (row0 + t) * 1024 + h * 128 + k;
            const float fg = __expf(bf2f(LFb[off])); FF[k * 8 + t] = fg; KK[k * 8 + t] = 1.0f - fg; QQ[k * 8 + t] = bf2f(Qb[off]); VV[t * 128 + k] = bf2f(Vb[off]); }
    }
    const int kq = tid >> 5, v4 = tid & 31;
    __syncthreads();
    f32x4 O[8];
#pragma unroll
    for (int t = 0; t < 8; ++t) O[t] = (f32x4){0.f, 0.f, 0.f, 0.f};
    const size_t sbase = ((size_t)(db * 8 + h) * 128 + 8 * kq) * 128 + 4 * v4;
    const float* S0 = p.state_hgrn + sbase;
    float* S1 = p.out + OFF_SS + sbase;
    f32x4 S4[8];
#pragma unroll
    for (int kk = 0; kk < 8; ++kk) S4[kk] = *(const f32x4*)(S0 + kk * 128);
#pragma unroll 1
    for (int kk = 0; kk < 8; ++kk) {
        const int k = 8 * kq + kk;
        const f32x4 f0 = *(const LAS f32x4*)(FF + k * 8), f1 = *(const LAS f32x4*)(FF + k * 8 + 4), k0 = *(const LAS f32x4*)(KK + k * 8), k1 = *(const LAS f32x4*)(KK + k * 8 + 4),
                    q0 = *(const LAS f32x4*)(QQ + k * 8), q1 = *(const LAS f32x4*)(QQ + k * 8 + 4);
        f32x4 s = S4[0];
#pragma unroll
        for (int t = 0; t < 8; ++t) { const float ft = t < 4 ? f0[t & 3] : f1[t & 3], kt = t < 4 ? k0[t & 3] : k1[t & 3], qt = t < 4 ? q0[t & 3] : q1[t & 3];
            const f32x4 vt = *(const LAS f32x4*)(VV + t * 128 + 4 * v4);
            s = s * ft + vt * kt; O[t] += s * qt; }
        *(f32x4*)(S1 + kk * 128) = s;
#pragma unroll
        for (int r = 0; r < 7; ++r) S4[r] = S4[r + 1];
    }
#pragma unroll
    for (int t = 0; t < 8; ++t) *(LAS f32x4*)(ORED + (kq * 8 + t) * 128 + 4 * v4) = O[t];
    __syncthreads();
    {   const int t = tid >> 6, vp = tid & 63; float o0 = 0.f, o1 = 0.f;
#pragma unroll
        for (int g = 0; g < 16; ++g) { o0 += ORED[(g * 8 + t) * 128 + 2 * vp]; o1 += ORED[(g * 8 + t) * 128 + 2 * vp + 1]; }
        *(unsigned*)(Vb + (row0 + t) * 1024 + h * 128 + 2 * vp) = cvt_pk_bf16(o0, o1);
    }
    __syncthreads();
}

constexpr int HC_QM = 0, HC_KM = 8704, HC_KMT = 17408, HC_VT = 27648, HC_E1 = 37888, HC_E2 = 38400, HC_GT = 38912;
__device__ __forceinline__ void hgrn_chain(const Params& p, LAS unsigned char* lds, int b, int h) {
    const int tid = threadIdx.x, lane = tid & 63, w = __builtin_amdgcn_readfirstlane(tid >> 6), fr = lane & 15, fq = lane >> 4;
    unsigned char* ws = p.ws;
    const bf16_t* Qb = (const bf16_t*)(ws + WS_GRP0 + G_Q * GRP_BYTES); const bf16_t* LFb = (const bf16_t*)(ws + WS_GRP0 + G_LF * GRP_BYTES);
    bf16_t* Vb = (bf16_t*)(ws + WS_GRP0 + G_V * GRP_BYTES);
    LAS bf16_t* QM = (LAS bf16_t*)(lds + HC_QM); LAS bf16_t* KM = (LAS bf16_t*)(lds + HC_KM); LAS bf16_t* KMT = (LAS bf16_t*)(lds + HC_KMT); LAS bf16_t* VT = (LAS bf16_t*)(lds + HC_VT);
    LAS float* E1 = (LAS float*)(lds + HC_E1); LAS float* E2 = (LAS float*)(lds + HC_E2); LAS float* GT = (LAS float*)(lds + HC_GT);
    const int k = tid & 127, tg = tid >> 7;
    int kperm; { const int x = k & 31; kperm = (k & ~31) + (x < 16 ? 8 * (x >> 2) + (x & 3) : 8 * ((x - 16) >> 2) + 4 + (x & 3)); }
    f32x4 S[8];
#pragma unroll
    for (int kt = 0; kt < 8; ++kt) S[kt] = (f32x4){0.f, 0.f, 0.f, 0.f};
    __syncthreads();
    for (int c = 0; c < 65; ++c) {
        const int ntok = c == 0 ? 16 : 32;
        const size_t row0 = c == 0 ? (size_t)ROW_META : (size_t)b * 2048 + 32 * (c - 1);
        float q[8], lf[8], vv[8];
#pragma unroll
        for (int j = 0; j < 8; ++j) { const int t = 8 * tg + j;
            if (t < ntok) { const size_t off = (row0 + t) * 1024 + h * 128 + k; q[j] = bf2f(Qb[off]); lf[j] = bf2f(LFb[off]); vv[j] = bf2f(Vb[off]); } else { q[j] = 0.f; lf[j] = 0.f; vv[j] = 0.f; } }
        float cs[8]; { float run = 0.f;
#pragma unroll
            for (int j = 0; j < 8; ++j) { run += lf[j]; cs[j] = run; } }
        GT[tg * 128 + k] = cs[7];
        __syncthreads();
        {   const float g0 = GT[k], g1 = GT[128 + k], g2 = GT[256 + k], g3 = GT[384 + k];
            const float pre = tg == 0 ? 0.f : tg == 1 ? g0 : tg == 2 ? g0 + g1 : g0 + g1 + g2;
            const float b15 = g0 + g1, b31 = b15 + g2 + g3;
#pragma unroll
            for (int j = 0; j < 8; ++j) { const int t = 8 * tg + j; const float bt = pre + cs[j];
                const float qm = q[j] * __expf(bt - b15), km = (1.0f - __expf(lf[j])) * __expf(b15 - bt);
                const bf16_t kmb = f2bf(km);
                QM[t * 136 + kperm] = f2bf(qm); KM[t * 136 + kperm] = kmb; KMT[k * 40 + t] = kmb; VT[k * 40 + t] = f2bf(vv[j]); }
            if (tg == 0) { E1[k] = __expf(b15); E2[k] = __expf(b31 - b15); }
        }
        __syncthreads();
#pragma unroll
        for (int kt = 0; kt < 8; ++kt) { const f32x4 e = *(const LAS f32x4*)(E1 + 16 * kt + 4 * fq); S[kt] = S[kt] * e; }
        bf16x8 qf[2][4], kf[2][4];
#pragma unroll
        for (int mt = 0; mt < 2; ++mt)
#pragma unroll
            for (int ks = 0; ks < 4; ++ks) { qf[mt][ks] = *(const LAS bf16x8*)(QM + (16 * mt + fr) * 136 + 32 * ks + 8 * fq); kf[mt][ks] = *(const LAS bf16x8*)(KM + (16 * mt + fr) * 136 + 32 * ks + 8 * fq); }
        f32x4 a00 = (f32x4){0.f, 0.f, 0.f, 0.f}, a10 = a00, a11 = a00;
#pragma unroll
        for (int ks = 0; ks < 4; ++ks) { a00 = mfma16(kf[0][ks], qf[0][ks], a00); a10 = mfma16(kf[0][ks], qf[1][ks], a10); a11 = mfma16(kf[1][ks], qf[1][ks], a11); }
#pragma unroll
        for (int i = 0; i < 4; ++i) { if (4 * fq + i > fr) { a00[i] = 0.f; a11[i] = 0.f; } }
        bf16x8 aop0, aop1;
        {   union { u32x4 u; bf16x8 v; } c0, c1;
            c0.u.x = cvt_pk_bf16(a00[0], a00[1]); c0.u.y = cvt_pk_bf16(a00[2], a00[3]); c0.u.z = 0u; c0.u.w = 0u;
            c1.u.x = cvt_pk_bf16(a10[0], a10[1]); c1.u.y = cvt_pk_bf16(a10[2], a10[3]); c1.u.z = cvt_pk_bf16(a11[0], a11[1]); c1.u.w = cvt_pk_bf16(a11[2], a11[3]);
            aop0 = c0.v; aop1 = c1.v; }
        f32x4 o0 = (f32x4){0.f, 0.f, 0.f, 0.f}, o1 = o0;
#pragma unroll
        for (int ks = 0; ks < 4; ++ks) { union { u32x4 u; bf16x8 v; } sf;
            sf.u.x = cvt_pk_bf16(S[2 * ks][0], S[2 * ks][1]); sf.u.y = cvt_pk_bf16(S[2 * ks][2], S[2 * ks][3]); sf.u.z = cvt_pk_bf16(S[2 * ks + 1][0], S[2 * ks + 1][1]); sf.u.w = cvt_pk_bf16(S[2 * ks + 1][2], S[2 * ks + 1][3]);
            o0 = mfma16(sf.v, qf[0][ks], o0); o1 = mfma16(sf.v, qf[1][ks], o1); }
        {   union { u32x4 u; bf16x8 v; } vs;
            const u32x2 lo = *(const LAS u32x2*)(VT + (16 * w + fr) * 40 + 4 * fq), hi = *(const LAS u32x2*)(VT + (16 * w + fr) * 40 + 16 + 4 * fq);
            vs.u.x = lo.x; vs.u.y = lo.y; vs.u.z = hi.x; vs.u.w = hi.y;
            o0 = mfma16(vs.v, aop0, o0); o1 = mfma16(vs.v, aop1, o1); }
        if (c > 0) {
            u32x2 y0, y1; y0.x = cvt_pk_bf16(o0[0], o0[1]); y0.y = cvt_pk_bf16(o0[2], o0[3]); y1.x = cvt_pk_bf16(o1[0], o1[1]); y1.y = cvt_pk_bf16(o1[2], o1[3]);
            *(u32x2*)(Vb + (row0 + fr) * 1024 + h * 128 + 16 * w + 4 * fq) = y0; *(u32x2*)(Vb + (row0 + 16 + fr) * 1024 + h * 128 + 16 * w + 4 * fq) = y1; }
        {   const bf16x8 vn = *(const LAS bf16x8*)(VT + (16 * w + fr) * 40 + 8 * fq);
#pragma unroll
            for (int kt = 0; kt < 8; ++kt) { const bf16x8 kmt = *(const LAS bf16x8*)(KMT + (16 * kt + fr) * 40 + 8 * fq); S[kt] = mfma16(kmt, vn, S[kt]);
                const f32x4 e = *(const LAS f32x4*)(E2 + 16 * kt + 4 * fq); S[kt] = S[kt] * e; } }
        __syncthreads();
    }
    float* SP = p.out + OFF_SP + ((size_t)(b * 8 + h) * 128) * 128;
#pragma unroll
    for (int kt = 0; kt < 8; ++kt)
#pragma unroll
        for (int i = 0; i < 4; ++i) SP[(size_t)(16 * kt + 4 * fq + i) * 128 + 16 * w + fr] = S[kt][i];
}

__device__ __forceinline__ void p2c_finish(const Params& p) {
    const int tid = threadIdx.x, lane = tid & 63, wave = tid >> 6;
    const int gw = blockIdx.x * NWAVES + wave, NGW = gridDim.x * NWAVES;
    unsigned char* ws = p.ws;
    const bf16_t* Vb = (const bf16_t*)(ws + WS_GRP0 + G_V * GRP_BYTES); bf16_t* OG = (bf16_t*)(ws + WS_GRP0 + G_OG * GRP_BYTES);
    const bf16_t* U = (const bf16_t*)(ws + WS_GRP0 + G_U * GRP_BYTES);
    float gn[16];
#pragma unroll
    for (int q = 0; q < 4; ++q) { const f32x4 v = *(const f32x4*)(p.gnorm + 16 * lane + 4 * q); gn[4 * q] = v.x; gn[4 * q + 1] = v.y; gn[4 * q + 2] = v.z; gn[4 * q + 3] = v.w; }
    for (int m = gw; m < M_MAIN; m += NGW) {
        const u32x4* op = (const u32x4*)(Vb + (size_t)m * 1024 + 16 * lane); u32x4* gp = (u32x4*)(OG + (size_t)m * 1024 + 16 * lane);
        const u32x4 oa = op[0], ob = op[1], ga = gp[0], gb = gp[1];
        float o[16], g[16];
        o[0] = bflo(oa.x); o[1] = bfhi(oa.x); o[2] = bflo(oa.y); o[3] = bfhi(oa.y); o[4] = bflo(oa.z); o[5] = bfhi(oa.z); o[6] = bflo(oa.w); o[7] = bfhi(oa.w);
        o[8] = bflo(ob.x); o[9] = bfhi(ob.x); o[10] = bflo(ob.y); o[11] = bfhi(ob.y); o[12] = bflo(ob.z); o[13] = bfhi(ob.z); o[14] = bflo(ob.w); o[15] = bfhi(ob.w);
        g[0] = bflo(ga.x); g[1] = bfhi(ga.x); g[2] = bflo(ga.y); g[3] = bfhi(ga.y); g[4] = bflo(ga.z); g[5] = bfhi(ga.z); g[6] = bflo(ga.w); g[7] = bfhi(ga.w);
        g[8] = bflo(gb.x); g[9] = bfhi(gb.x); g[10] = bflo(gb.y); g[11] = bfhi(gb.y); g[12] = bflo(gb.z); g[13] = bfhi(gb.z); g[14] = bflo(gb.w); g[15] = bfhi(gb.w);
        float ss = 0.f;
#pragma unroll
        for (int e = 0; e < 16; ++e) ss += o[e] * o[e];
        ss += __shfl_xor(ss, 1); ss += __shfl_xor(ss, 2); ss += __shfl_xor(ss, 4);
        const float rstd = 1.0f / sqrtf(ss * (1.0f / 128.0f) + EPS);
        float y[16];
#pragma unroll
        for (int e = 0; e < 16; ++e) y[e] = o[e] * rstd * gn[e] * g[e];
        u32x4 ya, yb;
        ya.x = cvt_pk_bf16(y[0], y[1]); ya.y = cvt_pk_bf16(y[2], y[3]); ya.z = cvt_pk_bf16(y[4], y[5]); ya.w = cvt_pk_bf16(y[6], y[7]);
        yb.x = cvt_pk_bf16(y[8], y[9]); yb.y = cvt_pk_bf16(y[10], y[11]); yb.z = cvt_pk_bf16(y[12], y[13]); yb.w = cvt_pk_bf16(y[14], y[15]);
        gp[0] = ya; gp[1] = yb;
    }
    const int gt = blockIdx.x * NTHREADS + tid, NGT = gridDim.x * NTHREADS;
    for (int e = gt; e < (NB + DBATCH) * 3 * 1024; e += NGT) {
        const int c = e & 1023, rk = e >> 10, sq = rk / 3, kk = rk % 3;
        if (sq < NB) p.out[OFF_CONVP + (size_t)(sq * 3 + kk) * 1024 + c] = bf2f(U[((size_t)sq * 2048 + 2045 + kk) * 1024 + c]);
        else { const int db = sq - NB; p.out[OFF_CONVS + (size_t)(db * 3 + kk) * 1024 + c] = bf2f(U[((size_t)ROW_SAMPLE + db * 8 + 5 + kk) * 1024 + c]); }
    }
}

__device__ __forceinline__ void p4b_rows(const Params& p) {
    const int tid = threadIdx.x, lane = tid & 63, wave = tid >> 6;
    const int gw = blockIdx.x * NWAVES + wave, NGW = gridDim.x * NWAVES;
    const float* MO = (const float*)(p.ws + WS_GRP0 + G_LF * GRP_BYTES);
    bf16_t* HN = (bf16_t*)(p.ws + WS_GRP0 + G_U * GRP_BYTES);
    const f32x4* g1 = (const f32x4*)(p.gains + 1024) + lane; const f32x4* g2 = (const f32x4*)(p.gains + 2048) + lane;
    for (int m = gw; m < M_MAIN; m += NGW) {
        const float* xrow = m < ROW_SAMPLE ? p.x_prompt + (size_t)m * D : p.x_sample + (size_t)(m - ROW_SAMPLE) * D;
        const f32x4* mr = (const f32x4*)(MO + (size_t)m * D) + lane; const f32x4* xr = (const f32x4*)xrow + lane;
        f32x4 v[4], x[4]; float s = 0.f;
#pragma unroll
        for (int j = 0; j < 4; ++j) { v[j] = mr[64 * j]; x[j] = xr[64 * j]; s += (v[j].x * v[j].x + v[j].y * v[j].y) + (v[j].z * v[j].z + v[j].w * v[j].w); }
        const float rstd = 1.0f / sqrtf(wave_sum(s) * (1.f / D) + EPS);
        float s2 = 0.f;
        f32x4* orow = (f32x4*)(p.out + OFF_Y + (size_t)m * D) + lane;
#pragma unroll
        for (int j = 0; j < 4; ++j) { const f32x4 gg = g1[64 * j]; x[j] = x[j] + v[j] * rstd * gg; orow[64 * j] = x[j]; s2 += (x[j].x * x[j].x + x[j].y * x[j].y) + (x[j].z * x[j].z + x[j].w * x[j].w); }
        const float rstd2 = 1.0f / sqrtf(wave_sum(s2) * (1.f / D) + EPS);
        u32x2* o8 = (u32x2*)(HN + (size_t)m * D) + lane;
#pragma unroll
        for (int j = 0; j < 4; ++j) { const f32x4 gg = g2[64 * j]; u32x2 wv; wv.x = cvt_pk_bf16(x[j].x * rstd2 * gg.x, x[j].y * rstd2 * gg.y); wv.y = cvt_pk_bf16(x[j].z * rstd2 * gg.z, x[j].w * rstd2 * gg.w); o8[64 * j] = wv; }
    }
}
__device__ __forceinline__ void p7_rows(const Params& p) {
    const int tid = threadIdx.x, lane = tid & 63, wave = tid >> 6;
    const int gw = blockIdx.x * NWAVES + wave, NGW = gridDim.x * NWAVES;
    const float* FFB = (const float*)(p.ws + WS_GRP0 + G_U * GRP_BYTES);
    const f32x4* g3 = (const f32x4*)(p.gains + 3072) + lane;
    for (int m = gw; m < M_MAIN; m += NGW) {
        const f32x4* fr_ = (const f32x4*)(FFB + (size_t)m * D) + lane;
        f32x4* orow = (f32x4*)(p.out + OFF_Y + (size_t)m * D) + lane;
        f32x4 v[4], x[4]; float s = 0.f;
#pragma unroll
        for (int j = 0; j < 4; ++j) { v[j] = fr_[64 * j]; x[j] = orow[64 * j]; s += (v[j].x * v[j].x + v[j].y * v[j].y) + (v[j].z * v[j].z + v[j].w * v[j].w); }
        const float rstd = 1.0f / sqrtf(wave_sum(s) * (1.f / D) + EPS);
#pragma unroll
        for (int j = 0; j < 4; ++j) { const f32x4 gg = g3[64 * j]; f32x4 r = x[j] + v[j] * rstd * gg;
#ifdef SANITIZE
#pragma unroll
            for (int e = 0; e < 4; ++e) if (!(fabsf(r[e]) < 1e30f)) r[e] = 1000.0f;
#endif
            orow[64 * j] = r; }
    }
}

__global__ void __launch_bounds__(NTHREADS, 2) fwd(Params p) {
    extern __shared__ __attribute__((aligned(16))) unsigned char lds_raw[];
    LAS unsigned char* lds = (LAS unsigned char*)lds_raw;
    unsigned char* ws = p.ws;
    const int G = gridDim.x, bid = blockIdx.x;
#ifndef PHMASK
#define PHMASK 0xFFF
#endif
#define IN(k) (((PHMASK >> (k)) & 1) && p.ph_lo <= (k) && (k) < p.ph_hi)
#ifndef CG_SEAMS
#define CG_SEAMS 0x001
#endif
#define SEAM(k) do { if (p.use_bar && IN(k) && IN((k) + 1)) { if ((CG_SEAMS >> (k)) & 1) cg::this_grid().sync(); else xcd_barrier(bar); } } while (0)
    XcdBarrier bar; bar.bar = (unsigned*)(ws + WS_CTL) + 4096; bar.x = 0; bar.st = nullptr;
    if (p.use_bar) {
        volatile LAS unsigned* st = (volatile LAS unsigned*)(lds + 131072);
        if (threadIdx.x < 16) st[threadIdx.x] = 0u;
        __syncthreads();
        bar = xcd_barrier_post((unsigned*)(ws + WS_CTL) + 4096, st);
    }
    bf16_t* GRP[6];
#pragma unroll
    for (int g = 0; g < 6; ++g) GRP[g] = (bf16_t*)(ws + WS_GRP0 + (size_t)g * GRP_BYTES);

    if (IN(0)) p0_prologue(p, lds);
    SEAM(0);
    if (IN(1)) {
        pg8::Gemm g{(const bf16_t*)((unsigned char*)p.out + OFF_SS * 4), (const bf16_t*)(ws + WS_WIN), M_PAD, DIN, D};
        pg8::StaticOrder S; S.init(M_PAD, DIN, G, bid);
        pg8::EpiProj E{ws, (unsigned char*)p.out, p.hgrn_lb};
        pg8::gemm_phase<pg8::EpiProj, pg8::StaticOrder, true, true>(lds, g, S, E);
    }
    SEAM(1);
    if (IN(2)) {
        rg_phase(p, lds, 0, bid, G);
    }
    SEAM(2);
    if (IN(3)) {
        if (bid < 64) hgrn_chain(p, lds, bid >> 3, bid & 7);
        else {
            for (int it = bid - 64; it < DBATCH * 8; it += G - 64) hgrn_sample_item(p, lds, it >> 3, it & 7);
            rg_phase(p, lds, 1, bid - 64, G - 64);
        }
    }
    SEAM(3);
    if (IN(4)) p2c_finish(p);
    SEAM(4);
    if (IN(5)) {
        pg8::Gemm g{GRP[G_GA], (const bf16_t*)(ws + WS_WA), M_MAIN, D, D};
        pg8::StaticOrder S; S.init(M_MAIN, D, G, bid);
        pg8::EpiGate<0> E{(const bf16_t*)p.out, nullptr, GRP[G_U]};
        pg8::gemm_phase<pg8::EpiGate<0>, pg8::StaticOrder, true, true>(lds, g, S, E);
    }
    SEAM(5);
    if (IN(6)) {
        pg8::Gemm g{GRP[G_OG], (const bf16_t*)(ws + WS_WB), M_MAIN, D, D};
        pg8::StaticOrder S; S.init(M_MAIN, D, G, bid);
        pg8::EpiGate<1> E{(const bf16_t*)((unsigned char*)p.out + GATE_BYTES), GRP[G_U], GRP[G_Q]};
        pg8::gemm_phase<pg8::EpiGate<1>, pg8::StaticOrder, true, true>(lds, g, S, E);
    }
    SEAM(6);
    if (IN(7)) {
        pg8::Gemm g{GRP[G_Q], (const bf16_t*)(ws + WS_WOUT), M_MAIN, D, D};
        pg8::StaticOrder S; S.init(M_MAIN, D, G, bid);
        pg8::EpiF32 E{(float*)GRP[G_LF]};
        pg8::gemm_phase<pg8::EpiF32, pg8::StaticOrder, true, true>(lds, g, S, E);
    }
    SEAM(7);
    if (IN(8)) p4b_rows(p);
    SEAM(8);
    if (IN(9)) {
        pg8::Gemm g{GRP[G_U], (const bf16_t*)(ws + WS_WUP), M_MAIN, DFF, D};
        pg8::StaticOrder S; S.init(M_MAIN, DFF, G, bid);
        pg8::EpiRelu2 E{GRP[G_Q]};
        pg8::gemm_phase<pg8::EpiRelu2, pg8::StaticOrder, true, true>(lds, g, S, E);
    }
    SEAM(9);
    if (IN(10)) {
        pg8::Gemm g{GRP[G_Q], (const bf16_t*)(ws + WS_WDN), M_MAIN, D, DFF};
        pg8::StaticOrder S; S.init(M_MAIN, D, G, bid);
        pg8::EpiF32 E{(float*)GRP[G_U]};
        pg8::gemm_phase<pg8::EpiF32, pg8::StaticOrder, true, true>(lds, g, S, E);
    }
    SEAM(10);
    if (IN(11)) p7_rows(p);
#undef IN
#undef SEAM
}

#ifndef N_LAUNCH_MODE
#define N_LAUNCH_MODE 1
#endif
extern "C" void kernel_launch(void* const* d_in, const int* in_sizes, int n_in, void* d_out, int out_size, void* d_ws, size_t ws_size, hipStream_t stream) {
    static int grid = 0;
    if (grid == 0) {
        if (n_in != 22 || (size_t)out_size != OUT_FLOATS || ws_size < WS_END) { fprintf(stderr, "kernel_launch: unexpected sizes (n_in %d, out %d, ws %zu); nothing launched\n", n_in, out_size, ws_size); grid = -1; return; }
        int dev = 0, cus = 0, per_cu = 0;
        if (hipGetDevice(&dev) != hipSuccess || hipDeviceGetAttribute(&cus, hipDeviceAttributeMultiprocessorCount, dev) != hipSuccess) { grid = -1; return; }
        if (hipFuncSetAttribute((const void*)fwd, hipFuncAttributeMaxDynamicSharedMemorySize, LDS_BYTES) != hipSuccess) { fprintf(stderr, "kernel_launch: hipFuncSetAttribute failed\n"); grid = -1; return; }
        if (hipOccupancyMaxActiveBlocksPerMultiprocessor(&per_cu, (const void*)fwd, NTHREADS, LDS_BYTES) != hipSuccess || per_cu < 1) { fprintf(stderr, "kernel_launch: occupancy query failed (%d)\n", per_cu); (void)hipGetLastError(); grid = -1; return; }
        grid = cus;
        if (grid != 256) fprintf(stderr, "kernel_launch: %d CUs; this kernel is laid out for 256\n", grid);
    }
    if (grid < 0) return;
    (void)hipMemsetAsync((char*)d_ws + WS_CTL, 0, CTL_ZERO_BYTES, stream);
    Params p{};
    const float** pp = (const float**)&p;
    for (int i = 0; i < 22; ++i) pp[i] = (const float*)d_in[i];
    p.out = (float*)d_out; p.ws = (unsigned char*)d_ws;
#if N_LAUNCH_MODE == 1
    p.ph_lo = 0; p.ph_hi = NPHASES; p.use_bar = 1;
    void* args[] = {&p};
    hipError_t e = hipLaunchCooperativeKernel((const void*)fwd, dim3(grid), dim3(NTHREADS), args, LDS_BYTES, stream);
    if (e != hipSuccess) fprintf(stderr, "kernel_launch: cooperative launch failed: %s (grid %d)\n", hipGetErrorString(e), grid);
#else
#ifndef NPH_RUN
#define NPH_RUN NPHASES
#endif
    for (int ph = 0; ph < NPH_RUN; ++ph) {
        p.ph_lo = ph; p.ph_hi = ph + 1; p.use_bar = 0;
        hipLaunchKernelGGL(fwd, dim3(grid), dim3(NTHREADS), LDS_BYTES, stream, p);
    }
#ifdef DUMP_V
    (void)hipMemcpyAsync((char*)d_out, (char*)d_ws + WS_GRP0 + G_V * GRP_BYTES, GATE_BYTES, hipMemcpyDeviceToDevice, stream);
    (void)hipMemcpyAsync((char*)d_out + GATE_BYTES, (char*)d_ws + WS_GRP0 + G_V * GRP_BYTES, GATE_BYTES, hipMemcpyDeviceToDevice, stream);
#endif
#ifdef DUMP_YAB
    (void)hipMemcpyAsync((char*)d_out, (char*)d_ws + WS_GRP0 + G_GA * GRP_BYTES, GATE_BYTES, hipMemcpyDeviceToDevice, stream);
    (void)hipMemcpyAsync((char*)d_out + GATE_BYTES, (char*)d_ws + WS_GRP0 + G_OG * GRP_BYTES, GATE_BYTES, hipMemcpyDeviceToDevice, stream);
#endif
#ifdef DUMP_YA
    (void)hipMemcpyAsync((char*)d_out, (char*)d_ws + WS_GRP0 + G_GA * GRP_BYTES, GATE_BYTES, hipMemcpyDeviceToDevice, stream);
    (void)hipMemcpyAsync((char*)d_out + GATE_BYTES, (char*)d_ws + WS_GRP0 + G_GA * GRP_BYTES, GATE_BYTES, hipMemcpyDeviceToDevice, stream);
#endif
#endif
}
```

```cpp
#include <hip/hip_runtime.h>
#include <hip/hip_cooperative_groups.h>
#include <cstdio>
#include <cstdint>
namespace cg = cooperative_groups;

constexpr int D = 1024, NB = 8, SEQ = 2048, NMETA = 16, DBATCH = 128, DSEQ = 8, DIN = 8192, DFF = 4096;
constexpr int ROW_SAMPLE = NB * SEQ;
constexpr int M_MAIN = ROW_SAMPLE + DBATCH * DSEQ;
constexpr int ROW_META = M_MAIN;
constexpr int M_REAL = M_MAIN + NMETA;
constexpr int M_PAD = 17664;
constexpr float EPS = 1e-6f;

constexpr size_t MiB = 1u << 20;
constexpr size_t WS_CTL = 0, CTL_ZERO_BYTES = 1 * MiB;
constexpr size_t WS_WIN = 1 * MiB, WS_WUP = 17 * MiB, WS_WDN = 25 * MiB, WS_WA = 33 * MiB, WS_WB = 35 * MiB, WS_WOUT = 37 * MiB, WS_WRG = 39 * MiB;
constexpr size_t AGG_BYTES = (size_t)NB * 33 * 1024 * 4;
constexpr size_t WS_AGGA = 39 * MiB + 512 * 1024, WS_AGGB = WS_AGGA + AGG_BYTES;
constexpr size_t GRP_BYTES = (size_t)M_PAD * 1024 * 2;
constexpr size_t WS_GRP0 = 42 * MiB;
constexpr size_t WS_END = WS_GRP0 + 6 * GRP_BYTES;
static_assert(WS_AGGB + AGG_BYTES <= WS_GRP0 && WS_END <= 256 * MiB, "d_ws map");
constexpr int G_U = 0, G_GA = 1, G_Q = 2, G_LF = 3, G_V = 4, G_OG = 5;
constexpr size_t OFF_Y = 0, OFF_CONVP = 17825792, OFF_HP = 17850368, OFF_SP = 17858560, OFF_CONVS = 18907136, OFF_HS = 19300352, OFF_SS = 19431424, OUT_FLOATS = 36208640;
constexpr size_t GATE_BYTES = (size_t)M_MAIN * 1024 * 2;
static_assert(2 * GATE_BYTES == OFF_CONVP * 4, "gates fill the y region exactly");
#define N_LAUNCH_MODE 1
namespace pg8 {
#define PG8_LAS __attribute__((address_space(3)))
typedef unsigned short bf16_t;
typedef short bf16x8 __attribute__((ext_vector_type(8)));
typedef float f32x4 __attribute__((ext_vector_type(4)));
typedef unsigned u32x4 __attribute__((ext_vector_type(4)));
constexpr int BM = 256, BK = 64, HALF = 128, HTB = HALF * BK * 2  , STAGE_BYTES = 8 * HTB, NXCD = 8, WGM = 8;

__host__ __device__ __forceinline__ int lds_byte(int r, int c) { const int st = (r >> 4) * 2 + (c >> 5), rr = r & 15, cc = c & 31, ob = rr * 64 + cc * 2; return st * 1024 + (ob ^ (((ob >> 9) & 1) << 5)); }
__host__ __device__ __forceinline__ void stage_rc(int b, int& R, int& C) { const int st = b / 1024, sb = b % 1024, swz = sb ^ (((sb >> 9) & 1) << 5); R = (st >> 1) * 16 + swz / 64; C = (st & 1) * 32 + (swz % 64) / 2; }
__host__ __device__ __forceinline__ int perm32(int rho) { const int n = rho >> 4, i = rho & 15; return 8 * (i >> 2) + 4 * n + (i & 3); }

struct Unit { int pm, pn; };
struct Gemm { const bf16_t* A; const bf16_t* Bt; int M, N, K; };

struct StaticOrder {
    int nM, nN, nwg, G, c;
    __host__ __device__ void init(int M, int N, int G_, int c_) { nM = M / BM; nN = N / BM; nwg = nM * nN; G = G_; c = c_; }
    __host__ __device__ bool next(int i, Unit& u) const {
        const long L = (long)i * G + c; if (L >= nwg) return false;
        int wgid = (int)L; { const int q = nwg / NXCD, r = nwg % NXCD, xcd = wgid % NXCD, off = wgid / NXCD; wgid = (xcd < r ? xcd * (q + 1) : r * (q + 1) + (xcd - r) * q) + off; }
        const int nig = WGM * nN, gid = wgid / nig, fm = gid * WGM, gsz = (nM - fm) < WGM ? (nM - fm) : WGM;
        u.pm = fm + ((wgid % nig) % gsz); u.pn = (wgid % nig) / gsz; return true;
    }
    __device__ __forceinline__ void a_ready(const Unit&) const {}
    __device__ __forceinline__ void done(const Unit&) const {}
};

typedef __bf16 bf16x2n __attribute__((ext_vector_type(2)));
typedef float f32x2n __attribute__((ext_vector_type(2)));
__device__ __forceinline__ unsigned cvt_pk_bf16(float lo, float hi) { const f32x2n v = {lo, hi}; const bf16x2n r = __builtin_convertvector(v, bf16x2n); return __builtin_bit_cast(unsigned, r); }
typedef float f32x2 __attribute__((ext_vector_type(2)));

__device__ __forceinline__ float fsig(float x) { return __builtin_amdgcn_rcpf(1.0f + __expf(-x)); }
__device__ __forceinline__ u32x4 pack8(const f32x4 a, const f32x4 b) { u32x4 w; w.x = cvt_pk_bf16(a[0], a[1]); w.y = cvt_pk_bf16(a[2], a[3]); w.z = cvt_pk_bf16(b[0], b[1]); w.w = cvt_pk_bf16(b[2], b[3]); return w; }
__device__ __forceinline__ float bf_lo(unsigned w) { return __uint_as_float(w << 16); }
__device__ __forceinline__ float bf_hi(unsigned w) { return __uint_as_float(w & 0xffff0000u); }

struct EpiProj {
    static constexpr bool PERM = true, AFTER_DRAIN = false;
    unsigned char* ws; unsigned char* outb; const float* hlb;
    __device__ __forceinline__ void operator()(const f32x4 (&acc)[2][2][4][2], const Unit& u, int wr, int wc, int fr, int fq) const {
        const int grp = u.pn >> 2;
        const int cbase = (u.pn & 3) * 256 + wc * 32 + 8 * fq;
        const int row0 = u.pm * BM + wr * 64 + fr;
        bf16_t* base; int rlim;
        if (grp < 6) { base = (bf16_t*)(ws + WS_GRP0 + (size_t)grp * GRP_BYTES); rlim = M_REAL; } else { base = (bf16_t*)(outb + (size_t)(grp - 6) * GATE_BYTES); rlim = M_MAIN; }
        const int mode = (grp == 0 || grp == 4) ? 0 : (grp == 1) ? 1 : (grp == 2 || grp == 5) ? 2 : (grp == 3) ? 3 : 4;
        float lbv[2][8];
#pragma unroll
        for (int bj = 0; bj < 2; ++bj)
#pragma unroll
            for (int e = 0; e < 8; ++e) lbv[bj][e] = 0.f;
        if (mode == 3) {
#pragma unroll
            for (int bj = 0; bj < 2; ++bj)
#pragma unroll
                for (int e = 0; e < 8; ++e) { const int c = cbase + bj * HALF + e; lbv[bj][e] = __builtin_amdgcn_rcpf(1.0f + __expf(hlb[1024 + c] - hlb[c])); }
        }
#pragma unroll
        for (int ai = 0; ai < 2; ++ai)
#pragma unroll
            for (int m = 0; m < 4; ++m) {
                const int r = row0 + ai * HALF + m * 16;
                if (r < rlim) {
                    bf16_t* rowp = base + (size_t)r * 1024 + cbase;
#pragma unroll
                    for (int bj = 0; bj < 2; ++bj) {
                        f32x4 v0 = acc[ai][bj][m][0], v1 = acc[ai][bj][m][1];
                        if (mode == 1) {
#pragma unroll
                            for (int e = 0; e < 4; ++e) { float x = v0[e]; v0[e] = x * fsig(x * (1.5957691216f + 0.0713548163f * x * x)); x = v1[e]; v1[e] = x * fsig(x * (1.5957691216f + 0.0713548163f * x * x)); }
                        } else if (mode == 2) {
#pragma unroll
                            for (int e = 0; e < 4; ++e) { v0[e] = v0[e] * fsig(v0[e]); v1[e] = v1[e] * fsig(v1[e]); }
                        } else if (mode == 3) {
#pragma unroll
                            for (int e = 0; e < 4; ++e) { const float l0 = lbv[bj][e], l1 = lbv[bj][4 + e]; v0[e] = __logf(l0 + (1.0f - l0) * fsig(v0[e])); v1[e] = __logf(l1 + (1.0f - l1) * fsig(v1[e])); }
                        } else if (mode == 4) {
#pragma unroll
                            for (int e = 0; e < 4; ++e) { v0[e] = fsig(v0[e]); v1[e] = fsig(v1[e]); }
                        }
                        *(u32x4*)(rowp + bj * HALF) = pack8(v0, v1);
                    }
                }
            }
    }
};

template <int WHICH> struct EpiGate {
    static constexpr bool PERM = true, AFTER_DRAIN = false;
    const bf16_t* gate; const bf16_t* prev; bf16_t* out;
    __device__ __forceinline__ void operator()(const f32x4 (&acc)[2][2][4][2], const Unit& u, int wr, int wc, int fr, int fq) const {
        const int cbase = u.pn * BM + wc * 32 + 8 * fq;
        const int row0 = u.pm * BM + wr * 64 + fr;
#pragma unroll
        for (int ai = 0; ai < 2; ++ai)
#pragma unroll
            for (int m = 0; m < 4; ++m) {
                const size_t off = (size_t)(row0 + ai * HALF + m * 16) * 1024 + cbase;
#pragma unroll
                for (int bj = 0; bj < 2; ++bj) {
                    const u32x4 g = *(const u32x4*)(gate + off + bj * HALF);
                    f32x4 v0 = acc[ai][bj][m][0], v1 = acc[ai][bj][m][1];
                    v0[0] *= bf_lo(g.x); v0[1] *= bf_hi(g.x); v0[2] *= bf_lo(g.y); v0[3] *= bf_hi(g.y);
                    v1[0] *= bf_lo(g.z); v1[1] *= bf_hi(g.z); v1[2] *= bf_lo(g.w); v1[3] *= bf_hi(g.w);
                    if (WHICH == 1) {
                        const u32x4 q = *(const u32x4*)(prev + off + bj * HALF);
                        v0[0] += bf_lo(q.x); v0[1] += bf_hi(q.x); v0[2] += bf_lo(q.y); v0[3] += bf_hi(q.y);
                        v1[0] += bf_lo(q.z); v1[1] += bf_hi(q.z); v1[2] += bf_lo(q.w); v1[3] += bf_hi(q.w);
                    }
                    *(u32x4*)(out + off + bj * HALF) = pack8(v0, v1);
                }
            }
    }
};

struct EpiF32 {
    static constexpr bool PERM = true, AFTER_DRAIN = false;
    float* out;
    __device__ __forceinline__ void operator()(const f32x4 (&acc)[2][2][4][2], const Unit& u, int wr, int wc, int fr, int fq) const {
        const int cbase = u.pn * BM + wc * 32 + 8 * fq;
        const int row0 = u.pm * BM + wr * 64 + fr;
#pragma unroll
        for (int ai = 0; ai < 2; ++ai)
#pragma unroll
            for (int m = 0; m < 4; ++m) {
                float* rowp = out + (size_t)(row0 + ai * HALF + m * 16) * 1024 + cbase;
#pragma unroll
                for (int bj = 0; bj < 2; ++bj) { *(f32x4*)(rowp + bj * HALF) = acc[ai][bj][m][0]; *(f32x4*)(rowp + bj * HALF + 4) = acc[ai][bj][m][1]; }
            }
    }
};

struct EpiRelu2 {
    static constexpr bool PERM = true, AFTER_DRAIN = false;
    bf16_t* out;
    __device__ __forceinline__ void operator()(const f32x4 (&acc)[2][2][4][2], const Unit& u, int wr, int wc, int fr, int fq) const {
        const int cbase = u.pn * BM + wc * 32 + 8 * fq;
        const int row0 = u.pm * BM + wr * 64 + fr;
#pragma unroll
        for (int ai = 0; ai < 2; ++ai)
#pragma unroll
            for (int m = 0; m < 4; ++m) {
                bf16_t* rowp = out + (size_t)(row0 + ai * HALF + m * 16) * 4096 + cbase;
#pragma unroll
                for (int bj = 0; bj < 2; ++bj) {
                    f32x4 v0 = acc[ai][bj][m][0], v1 = acc[ai][bj][m][1];
#pragma unroll
                    for (int e = 0; e < 4; ++e) { const float a = fmaxf(v0[e], 0.f), b = fmaxf(v1[e], 0.f); v0[e] = a * a; v1[e] = b * b; }
                    *(u32x4*)(rowp + bj * HALF) = pack8(v0, v1);
                }
            }
    }
};

template <class Epi, class Sched, bool ALIGN_EPI = false, bool SP2 = false>
__device__ __forceinline__ void gemm_phase(PG8_LAS unsigned char* lds, const Gemm g, const Sched& S, const Epi& E) {
    const int tid = threadIdx.x, wid = __builtin_amdgcn_readfirstlane(tid >> 6), lane = tid & 63, wr = wid >> 2, wc = wid & 3, fr = lane & 15, fq = lane >> 4;
    const int K = g.K, nt = K / BK;
    unsigned voffA[2], voffB[2];
#pragma unroll
    for (int i = 0; i < 2; ++i) { int R, C; stage_rc(tid * 16 + i * 8192, R, C); const int Rb = Epi::PERM ? ((R & ~31) + perm32(R & 31)) : R;
        voffA[i] = (unsigned)(R * K + C) * 2u; voffB[i] = (unsigned)(Rb * K + C) * 2u; }
    const size_t kstep = (size_t)(BK * 2);
    const size_t hstep = (size_t)HALF * K * 2;
    const size_t tstep = 2 * hstep;
    const unsigned ldsw = (unsigned)wid * 1024u;
    const int aoff = lds_byte(wr * 64 + fr, fq * 8), boff = lds_byte(wc * 32 + fr, fq * 8);
#define PG8_SA(b, h) (((b) * 2 + (h)) * HTB)
#define PG8_SB(b, h) ((4 + (b) * 2 + (h)) * HTB)
#define PG8_STAGE(bufoff, gbase, voff) do { _Pragma("unroll") for (int _i = 0; _i < 2; ++_i) \
        __builtin_amdgcn_global_load_lds((const unsigned*)((const char*)(gbase) + (voff)[_i]), (PG8_LAS unsigned*)(lds + (bufoff) + ldsw + _i * 8192), 16, 0, 0); } while (0)
#define PG8_LDA(dst, b, h) do { _Pragma("unroll") for (int m = 0; m < 4; ++m) _Pragma("unroll") for (int k = 0; k < 2; ++k) dst[m][k] = *(const PG8_LAS bf16x8*)(lds + PG8_SA(b, h) + aoff + m * 2048 + k * 1024); } while (0)
#define PG8_LDB(dst, b, h) do { _Pragma("unroll") for (int n = 0; n < 2; ++n) _Pragma("unroll") for (int k = 0; k < 2; ++k) dst[n][k] = *(const PG8_LAS bf16x8*)(lds + PG8_SB(b, h) + boff + n * 2048 + k * 1024); } while (0)
#define PG8_MMA(ai, bj, At, Bt) do { __builtin_amdgcn_s_setprio(1); _Pragma("unroll") for (int m = 0; m < 4; ++m) _Pragma("unroll") for (int n = 0; n < 2; ++n) _Pragma("unroll") for (int k = 0; k < 2; ++k) \
        acc[ai][bj][m][n] = __builtin_amdgcn_mfma_f32_16x16x32_bf16(Bt[n][k], At[m][k], acc[ai][bj][m][n], 0, 0, 0); __builtin_amdgcn_s_setprio(0); } while (0)
#define PG8_WAIT_V(n) asm volatile("s_waitcnt vmcnt(" #n ")" ::: "memory")
#define PG8_WAIT_L(n) asm volatile("s_waitcnt lgkmcnt(" #n ")" ::: "memory")
#define PG8_BAR __builtin_amdgcn_s_barrier()
#define PG8_SCHED __builtin_amdgcn_sched_barrier(0)
    Unit cur, nxt; int ui = 0;
    if (!S.next(0, cur)) return;
    f32x4 acc[2][2][4][2];
#pragma unroll
    for (int a = 0; a < 2; ++a)
#pragma unroll
        for (int b = 0; b < 2; ++b)
#pragma unroll
            for (int m = 0; m < 4; ++m)
#pragma unroll
                for (int n = 0; n < 2; ++n) acc[a][b][m][n] = (f32x4){0.f, 0.f, 0.f, 0.f};
    bf16x8 At[4][2], B0[2][2], B1[2][2];
    const char* cA = (const char*)g.A + (size_t)cur.pm * tstep; const char* cB = (const char*)g.Bt + (size_t)cur.pn * tstep;
    S.a_ready(cur);
    if constexpr (SP2) {
        PG8_STAGE(PG8_SB(0, 0), cB, voffB); PG8_STAGE(PG8_SB(0, 1), cB + hstep, voffB); PG8_STAGE(PG8_SA(0, 0), cA, voffA); PG8_STAGE(PG8_SA(0, 1), cA + hstep, voffA);
        if (wr == 1) PG8_BAR;
        PG8_WAIT_V(2); PG8_BAR;
        PG8_STAGE(PG8_SB(1, 0), cB + kstep, voffB); PG8_STAGE(PG8_SA(1, 0), cA + kstep, voffA); PG8_STAGE(PG8_SB(1, 1), cB + hstep + kstep, voffB);
        PG8_WAIT_V(6); PG8_BAR;
    } else {
        PG8_STAGE(PG8_SB(0, 0), cB, voffB); PG8_STAGE(PG8_SA(0, 0), cA, voffA); PG8_STAGE(PG8_SB(0, 1), cB + hstep, voffB); PG8_STAGE(PG8_SA(0, 1), cA + hstep, voffA);
        if (wr == 1) PG8_BAR;
        PG8_WAIT_V(4); PG8_BAR;
        PG8_STAGE(PG8_SB(1, 0), cB + kstep, voffB); PG8_STAGE(PG8_SA(1, 0), cA + kstep, voffA); PG8_STAGE(PG8_SB(1, 1), cB + hstep + kstep, voffB);
        PG8_WAIT_V(6); PG8_BAR;
    }
    for (;;) {
        const bool has_next = S.next(ui + 1, nxt);
        const char* nA = has_next ? (const char*)g.A + (size_t)nxt.pm * tstep : cA; const char* nB = has_next ? (const char*)g.Bt + (size_t)nxt.pn * tstep : cB;
        for (int t = 0; t < nt; t += 2) {
            const bool last = (t == nt - 2);
            const char* a1 = cA + (size_t)(t + 1) * kstep;
            const char* a2 = last ? nA : cA + (size_t)(t + 2) * kstep; const char* b2 = last ? nB : cB + (size_t)(t + 2) * kstep;
            const char* a3 = a2 + kstep; const char* b3 = b2 + kstep;
            if (last && has_next) S.a_ready(nxt);
            if constexpr (SP2) {
            PG8_LDB(B0, 0, 0); PG8_LDB(B1, 0, 1); PG8_SCHED; PG8_LDA(At, 0, 0); PG8_STAGE(PG8_SA(1, 1), a1 + hstep, voffA);
            PG8_WAIT_V(8); PG8_WAIT_L(0); PG8_BAR; PG8_MMA(0, 0, At, B0); PG8_MMA(0, 1, At, B1); PG8_BAR; PG8_SCHED;
            PG8_LDA(At, 0, 1); PG8_STAGE(PG8_SB(0, 0), b2, voffB); PG8_STAGE(PG8_SB(0, 1), b2 + hstep, voffB); PG8_STAGE(PG8_SA(0, 0), a2, voffA);
            PG8_WAIT_V(8); PG8_WAIT_L(0); PG8_BAR; PG8_MMA(1, 0, At, B0); PG8_MMA(1, 1, At, B1); PG8_BAR; PG8_SCHED;
            PG8_LDB(B0, 1, 0); PG8_LDB(B1, 1, 1); PG8_SCHED; PG8_LDA(At, 1, 0); PG8_STAGE(PG8_SA(0, 1), a2 + hstep, voffA);
            PG8_WAIT_V(8); PG8_WAIT_L(0); PG8_BAR; PG8_MMA(0, 0, At, B0); PG8_MMA(0, 1, At, B1); PG8_BAR; PG8_SCHED;
            PG8_LDA(At, 1, 1); PG8_STAGE(PG8_SB(1, 0), b3, voffB); PG8_STAGE(PG8_SB(1, 1), b3 + hstep, voffB); PG8_STAGE(PG8_SA(1, 0), a3, voffA);
            PG8_WAIT_V(8); PG8_WAIT_L(0); PG8_BAR; PG8_MMA(1, 0, At, B0); PG8_MMA(1, 1, At, B1); PG8_BAR; PG8_SCHED;
            } else {
            PG8_LDB(B0, 0, 0); PG8_SCHED; PG8_LDA(At, 0, 0); PG8_STAGE(PG8_SA(1, 1), a1 + hstep, voffA);
            PG8_WAIT_L(8); PG8_BAR; PG8_WAIT_L(0); PG8_MMA(0, 0, At, B0); PG8_BAR; PG8_SCHED;
            PG8_LDB(B1, 0, 1); PG8_STAGE(PG8_SB(0, 0), b2, voffB);
            PG8_BAR; PG8_WAIT_L(0); PG8_MMA(0, 1, At, B1); PG8_BAR;
            PG8_LDA(At, 0, 1); PG8_STAGE(PG8_SA(0, 0), a2, voffA);
            PG8_BAR; PG8_WAIT_L(0); PG8_MMA(1, 0, At, B0); PG8_BAR; PG8_SCHED;
            PG8_STAGE(PG8_SB(0, 1), b2 + hstep, voffB);
            PG8_WAIT_V(6); PG8_BAR; PG8_MMA(1, 1, At, B1); PG8_BAR;
            PG8_LDB(B0, 1, 0); PG8_SCHED; PG8_LDA(At, 1, 0); PG8_STAGE(PG8_SA(0, 1), a2 + hstep, voffA);
            PG8_WAIT_L(8); PG8_BAR; PG8_WAIT_L(0); PG8_MMA(0, 0, At, B0); PG8_BAR; PG8_SCHED;
            PG8_LDB(B1, 1, 1); PG8_STAGE(PG8_SB(1, 0), b3, voffB);
            PG8_BAR; PG8_WAIT_L(0); PG8_MMA(0, 1, At, B1); PG8_BAR;
            PG8_LDA(At, 1, 1); PG8_STAGE(PG8_SA(1, 0), a3, voffA);
            PG8_BAR; PG8_WAIT_L(0); PG8_MMA(1, 0, At, B0); PG8_BAR; PG8_SCHED;
            PG8_STAGE(PG8_SB(1, 1), b3 + hstep, voffB);
            PG8_WAIT_V(6); PG8_BAR; PG8_MMA(1, 1, At, B1); PG8_BAR;
            }
        }
        if constexpr (ALIGN_EPI) { if (wr == 0) PG8_BAR; }
        if constexpr (!Epi::AFTER_DRAIN) { E(acc, cur, wr, wc, fr, fq); S.done(cur); }
        if (!has_next) break;
#pragma unroll
        for (int a = 0; a < 2; ++a)
#pragma unroll
            for (int b = 0; b < 2; ++b)
#pragma unroll
                for (int m = 0; m < 4; ++m)
#pragma unroll
                    for (int n = 0; n < 2; ++n) acc[a][b][m][n] = (f32x4){0.f, 0.f, 0.f, 0.f};
        cur = nxt; cA = nA; cB = nB; ++ui;
        if constexpr (ALIGN_EPI) { if (wr == 1) PG8_BAR; }
    }
    PG8_WAIT_V(0);
    if constexpr (!ALIGN_EPI) { if (wr == 0) PG8_BAR; }
    PG8_BAR;
    if constexpr (Epi::AFTER_DRAIN) { E.fused(acc, cur, wr, wc, fr, fq, lds, wid, lane); S.done(cur); }
#undef PG8_SA
#undef PG8_SB
#undef PG8_STAGE
#undef PG8_LDA
#undef PG8_LDB
#undef PG8_MMA
#undef PG8_WAIT_V
#undef PG8_WAIT_L
#undef PG8_BAR
#undef PG8_SCHED
}
}

#define LAS __attribute__((address_space(3)))
typedef unsigned short bf16_t;
typedef short bf16x8 __attribute__((ext_vector_type(8)));
typedef float f32x4 __attribute__((ext_vector_type(4)));
typedef unsigned u32x4 __attribute__((ext_vector_type(4)));
typedef unsigned u32x2 __attribute__((ext_vector_type(2)));
constexpr int NWAVES = 8, NTHREADS = 512;
constexpr int LDS_BYTES = 147456;
constexpr int NPHASES = 12;

struct Params {
    const float *x_prompt, *x_sample, *state_conv, *state_rglru, *state_hgrn, *meta, *gains, *w_in, *conv_w, *conv_b, *rg_w, *rg_b, *ig_w, *ig_b, *lam, *hgrn_lb, *gnorm, *w_a, *w_b, *w_out, *w_up, *w_down;
    float* out; unsigned char* ws;
    int ph_lo, ph_hi, use_bar, pad;
};

using pg8::cvt_pk_bf16;
__device__ __forceinline__ float bflo(unsigned w) { return __uint_as_float(w << 16); }
__device__ __forceinline__ float bfhi(unsigned w) { return __uint_as_float(w & 0xffff0000u); }
__device__ __forceinline__ float bf2f(bf16_t h) { return __uint_as_float((unsigned)h << 16); }
__device__ __forceinline__ bf16_t f2bf(float f) { return (bf16_t)(cvt_pk_bf16(f, 0.f) & 0xffffu); }
__device__ __forceinline__ float fsig(float x) { return __builtin_amdgcn_rcpf(1.0f + __expf(-x)); }
__device__ __forceinline__ float wave_sum(float v) {
#pragma unroll
    for (int o = 1; o < 64; o <<= 1) v += __shfl_xor(v, o);
    return v;
}
__device__ __forceinline__ f32x4 mfma16(bf16x8 first, bf16x8 second, f32x4 c) { return __builtin_amdgcn_mfma_f32_16x16x32_bf16(first, second, c, 0, 0, 0); }

#define XB_TMO      128
#define XB_XCNT(j)  (256  + 64 * (j))
#define XB_XSUB(j)  (1280 + 64 * (j))
#define XB_XGEN(j)  (2304 + 64 * (j))
#define XB_TOP      3328
#define XB_TOPGEN   3392
#define XCD_BAR_WORDS 3456
#define XB_SPIN_CAP (1u << 18)

__device__ __forceinline__ unsigned xb_ld(unsigned* p)              { return __hip_atomic_load(p, __ATOMIC_RELAXED, __HIP_MEMORY_SCOPE_AGENT); }
__device__ __forceinline__ unsigned xb_add(unsigned* p, unsigned v) { return __hip_atomic_fetch_add(p, v, __ATOMIC_RELAXED, __HIP_MEMORY_SCOPE_AGENT); }
__device__ __forceinline__ unsigned xb_xcc_id() { return (unsigned)__builtin_amdgcn_s_getreg((3 << 11) | 20) & 0xFu; }
#define XB_SPIN(cond, bar) do { unsigned _sp = 0; while (cond) { __builtin_amdgcn_s_sleep(1); \
    if ((++_sp & 255u) == 0u) { if (xb_ld(&(bar)[XB_TMO])) break; if (_sp > XB_SPIN_CAP) { atomicAdd(&(bar)[XB_TMO], 1u); break; } } } } while (0)

struct XcdBarrier {
    unsigned* bar; unsigned x;
    volatile LAS unsigned* st;
};

__device__ __forceinline__ XcdBarrier xcd_barrier_post(unsigned* bar, volatile LAS unsigned* st) {
    XcdBarrier b; b.bar = bar; b.x = xb_xcc_id(); b.st = st;
    if (threadIdx.x == 0) (void)xb_add(&bar[XB_XCNT(b.x)], 1u);
    return b;
}
__device__ __forceinline__ void xcd_barrier_complete(unsigned* bar, unsigned x, unsigned& nloc, unsigned& nx) {
    const unsigned G = gridDim.x * gridDim.y * gridDim.z;
    unsigned sum, cnt, mine, sp = 0u;
    for (;;) {
        sum = 0u; cnt = 0u; mine = 0u;
#pragma unroll
        for (unsigned j = 0; j < 16; ++j) { const unsigned c = xb_ld(&bar[XB_XCNT(j)]); sum += c; cnt += (c > 0u) ? 1u : 0u; mine = (j == x) ? c : mine; }
        if (sum == G) break;
        __builtin_amdgcn_s_sleep(1);
        if ((++sp & 255u) == 0u) { if (xb_ld(&bar[XB_TMO])) break; if (sp > XB_SPIN_CAP) { atomicAdd(&bar[XB_TMO], 1u); break; } }
    }
    nloc = mine > 0u ? mine : 1u; nx = cnt > 0u ? cnt : 1u;
}

__device__ __forceinline__ void xcd_barrier(const XcdBarrier& b) {
    asm volatile("s_waitcnt vmcnt(0)" ::: "memory");
    __syncthreads();
    if (threadIdx.x == 0) {
        unsigned* bar = b.bar;
        __builtin_amdgcn_s_waitcnt(0);
        unsigned nloc = b.st[0], nx = b.st[1];
        if (nloc == 0u) { xcd_barrier_complete(bar, b.x, nloc, nx); b.st[0] = nloc; b.st[1] = nx; }
        const unsigned old = xb_add(&bar[XB_XSUB(b.x)], 1u);
        const unsigned gen = old / nloc;
        if (old + 1u == (gen + 1u) * nloc) {
            __builtin_amdgcn_fence(__ATOMIC_RELEASE, "agent");
            asm volatile("s_waitcnt vmcnt(0)" ::: "memory");
            const unsigned og = xb_add(&bar[XB_TOP], 1u);
            const unsigned tg = og / nx;
            if (og + 1u == (tg + 1u) * nx) xb_add(&bar[XB_TOPGEN], 1u);
            else XB_SPIN(xb_ld(&bar[XB_TOPGEN]) == tg, bar);
            __builtin_amdgcn_fence(__ATOMIC_ACQUIRE, "agent");
            xb_add(&bar[XB_XGEN(b.x)], 1u);
            asm volatile("s_waitcnt vmcnt(0)" ::: "memory");
        } else {
            XB_SPIN(xb_ld(&bar[XB_XGEN(b.x)]) == gen, bar);
            __builtin_amdgcn_fence(__ATOMIC_ACQUIRE, "agent");
            asm volatile("s_waitcnt vmcnt(0)" ::: "memory");
        }
    }
    __syncthreads();
}


__device__ __forceinline__ void p0_transpose_item(const float* W, int K, int N, bf16_t* WT, int row_off, LAS float* scr, int item, int lane) {
    const int nblk = N / 32, kb = item / nblk, nb = item % nblk, k0 = 64 * kb, n0 = 32 * nb;
#pragma unroll 8
    for (int i = 0; i < 32; ++i) { const int kk = 2 * i + (lane >> 5); scr[kk * 33 + (lane & 31)] = W[(size_t)(k0 + kk) * N + n0 + (lane & 31)]; }
    asm volatile("s_waitcnt lgkmcnt(0)" ::: "memory");
    const int c = lane & 7;
#pragma unroll
    for (int j = 0; j < 4; ++j) { const int n = (lane >> 3) + 8 * j; const LAS float* s = scr + (8 * c) * 33 + n;
        u32x4 o; o.x = cvt_pk_bf16(s[0 * 33], s[1 * 33]); o.y = cvt_pk_bf16(s[2 * 33], s[3 * 33]); o.z = cvt_pk_bf16(s[4 * 33], s[5 * 33]); o.w = cvt_pk_bf16(s[6 * 33], s[7 * 33]);
        *(u32x4*)(WT + (size_t)(row_off + n0 + n) * K + k0 + 8 * c) = o; }
    asm volatile("s_waitcnt lgkmcnt(0)" ::: "memory");
}
__device__ __forceinline__ void rms_row_to_bf16(const float* xrow, const float* g, bf16_t* orow, int lane) {
    const f32x4* xr = (const f32x4*)xrow + lane; const f32x4* gr = (const f32x4*)g + lane;
    f32x4 v[4]; float s = 0.f;
#pragma unroll
    for (int j = 0; j < 4; ++j) { v[j] = xr[64 * j]; s += (v[j].x * v[j].x + v[j].y * v[j].y) + (v[j].z * v[j].z + v[j].w * v[j].w); }
    const float rstd = 1.0f / sqrtf(wave_sum(s) * (1.f / D) + EPS);
    u32x2* o8 = (u32x2*)orow + lane;
#pragma unroll
    for (int j = 0; j < 4; ++j) { const f32x4 gg = gr[64 * j]; u32x2 w; w.x = cvt_pk_bf16(v[j].x * rstd * gg.x, v[j].y * rstd * gg.y); w.y = cvt_pk_bf16(v[j].z * rstd * gg.z, v[j].w * rstd * gg.w); o8[64 * j] = w; }
}
__device__ __forceinline__ void p0_prologue(const Params& p, LAS unsigned char* lds) {
    const int tid = threadIdx.x, lane = tid & 63, wave = __builtin_amdgcn_readfirstlane(tid >> 6);
    LAS float* scr = (LAS float*)(lds + wave * 16384);
    const int gw = blockIdx.x * NWAVES + wave, NGW = gridDim.x * NWAVES;
    constexpr int I_IN = (D / 64) * (DIN / 32), I_UP = (D / 64) * (DFF / 32), I_DN = (DFF / 64) * (D / 32), I_SQ = (D / 64) * (D / 32), I_RG = 8;
    constexpr int NITEMS = I_IN + I_UP + I_DN + 3 * I_SQ + 16 * I_RG;
    unsigned char* ws = p.ws;
    for (int it = gw; it < NITEMS; it += NGW) {
        int r = it;
        if (r < I_IN) { p0_transpose_item(p.w_in, D, DIN, (bf16_t*)(ws + WS_WIN), 0, scr, r, lane); continue; } r -= I_IN;
        if (r < I_UP) { p0_transpose_item(p.w_up, D, DFF, (bf16_t*)(ws + WS_WUP), 0, scr, r, lane); continue; } r -= I_UP;
        if (r < I_DN) { p0_transpose_item(p.w_down, DFF, D, (bf16_t*)(ws + WS_WDN), 0, scr, r, lane); continue; } r -= I_DN;
        if (r < I_SQ) { p0_transpose_item(p.w_a, D, D, (bf16_t*)(ws + WS_WA), 0, scr, r, lane); continue; } r -= I_SQ;
        if (r < I_SQ) { p0_transpose_item(p.w_b, D, D, (bf16_t*)(ws + WS_WB), 0, scr, r, lane); continue; } r -= I_SQ;
        if (r < I_SQ) { p0_transpose_item(p.w_out, D, D, (bf16_t*)(ws + WS_WOUT), 0, scr, r, lane); continue; } r -= I_SQ;
        { const int hm = r / I_RG, ii = r % I_RG, h = hm >> 1, which = hm & 1;
          p0_transpose_item((which ? p.ig_w : p.rg_w) + (size_t)h * 128 * 128, 128, 128, (bf16_t*)(ws + WS_WRG), h * 256 + which * 128, scr, ii, lane); }
    }
    bf16_t* XN = (bf16_t*)((unsigned char*)p.out + OFF_SS * 4);
    for (int m = gw; m < M_PAD; m += NGW) {
        bf16_t* orow = XN + (size_t)m * D;
        if (m < M_REAL) {
            const float* xrow = m < ROW_SAMPLE ? p.x_prompt + (size_t)m * D : m < M_MAIN ? p.x_sample + (size_t)(m - ROW_SAMPLE) * D : p.meta + (size_t)(m - ROW_META) * D;
            rms_row_to_bf16(xrow, p.gains, orow, lane);
        } else {
            u32x2* o8 = (u32x2*)orow + lane;
#pragma unroll
            for (int j = 0; j < 4; ++j) o8[64 * j] = (u32x2){0u, 0u};
        }
    }
}

__device__ __forceinline__ float softplus_neg(float lam) {
    const float x = __expf(-lam);
    return x < 0.03f ? x * (1.0f - x * (0.5f - x * (1.0f / 3.0f - 0.25f * x))) : __logf(1.0f + x);
}
__device__ __forceinline__ float neg_expm1(float y) {
    if (y > -0.3f) { float q = 1.0f / 5040.0f; q = q * y + 1.0f / 720.0f; q = q * y + 1.0f / 120.0f; q = q * y + 1.0f / 24.0f; q = q * y + 1.0f / 6.0f; q = q * y + 0.5f; q = q * y + 1.0f; return -y * q; }
    return 1.0f - __expf(y);
}
constexpr int RG_WB = 0, RG_UCB = 69632, RG_UCF = 87040;
__device__ __forceinline__ void rg_phase(const Params& p, LAS unsigned char* lds, int mode, int wg, int nwg) {
    const int tid = threadIdx.x, lane = tid & 63, w = __builtin_amdgcn_readfirstlane(tid >> 6), fr = lane & 15, fq = lane >> 4;
    const int h = wg & 7, idx = wg >> 3, nidx = nwg >> 3;
    unsigned char* ws = p.ws;
    const bf16_t* U = (const bf16_t*)(ws + WS_GRP0 + G_U * GRP_BYTES);
    bf16_t* GA = (bf16_t*)(ws + WS_GRP0 + G_GA * GRP_BYTES);
    float* AGGA = (float*)(ws + WS_AGGA); float* AGGB = (float*)(ws + WS_AGGB);
    LAS unsigned char* WB = lds + RG_WB; LAS unsigned char* UCB = lds + RG_UCB; LAS float* UCF = (LAS float*)(lds + RG_UCF);
    __syncthreads();
    {   const bf16_t* wsrc = (const bf16_t*)(ws + WS_WRG) + (size_t)h * 256 * 128;
#pragma unroll
        for (int it = 0; it < 8; ++it) { const int row = (tid >> 4) + 32 * it, ch = tid & 15; *(LAS u32x4*)(WB + row * 272 + ch * 16) = *(const u32x4*)(wsrc + row * 128 + ch * 8); }
    }
    __syncthreads();
    bf16x8 bw[2][4];
#pragma unroll
    for (int nt = 0; nt < 2; ++nt)
#pragma unroll
        for (int ks = 0; ks < 4; ++ks) bw[nt][ks] = *(const LAS bf16x8*)(WB + (nt * 128 + 16 * w + fr) * 272 + 64 * ks + 16 * fq);
    const int c0 = h * 128 + 16 * w + 4 * fq;
    const f32x4 rgb = *(const f32x4*)(p.rg_b + c0), igb = *(const f32x4*)(p.ig_b + c0), lam4 = *(const f32x4*)(p.lam + c0);
    f32x4 sp8;
#pragma unroll
    for (int i = 0; i < 4; ++i) sp8[i] = 8.0f * softplus_neg(lam4[i]);
    const int nunits = mode == 0 ? NB * 33 + 16 : NB * 32;
    const int crow = tid >> 3, cgp = tid & 7, ch0 = h * 128 + 16 * cgp;
    for (int ui = idx; ui < nunits; ui += nidx) {
        int b = 0, j = 0, st = 0; bool sample = false, full = true;
        if (mode == 0) { if (ui < NB * 33) { b = ui / 33; j = ui % 33; full = false; } else { sample = true; st = ui - NB * 33; } }
        else { b = ui >> 5; j = (ui & 31) + 1; }
        {
            float uc[16];
            {   const f32x4* cb = (const f32x4*)(p.conv_b + ch0);
#pragma unroll
                for (int q = 0; q < 4; ++q) { const f32x4 v = cb[q]; uc[4 * q] = v.x; uc[4 * q + 1] = v.y; uc[4 * q + 2] = v.z; uc[4 * q + 3] = v.w; } }
            const bool rowvalid = sample || j > 0 || crow < 16;
#pragma unroll
            for (int k = 0; k < 4; ++k) {
                const bf16_t* src = nullptr; const float* srcf = nullptr;
                if (sample) { const int seg = crow >> 3, t = crow & 7, db = 8 * st + seg, ts = t + k - 3;
                    if (ts >= 0) src = U + (size_t)(ROW_SAMPLE + db * 8 + ts) * 1024 + ch0; else srcf = p.state_conv + ((size_t)db * 3 + ts + 3) * 1024 + ch0; }
                else { const int pp = (j == 0 ? crow : 16 + 64 * (j - 1) + crow) + k - 3;
                    if (rowvalid && pp >= 0) { const size_t grow = pp < 16 ? (size_t)(ROW_META + pp) : (size_t)b * 2048 + pp - 16; src = U + grow * 1024 + ch0; } }
                float val[16];
                if (src) { const u32x4 a = ((const u32x4*)src)[0], b2 = ((const u32x4*)src)[1];
                    val[0] = bflo(a.x); val[1] = bfhi(a.x); val[2] = bflo(a.y); val[3] = bfhi(a.y); val[4] = bflo(a.z); val[5] = bfhi(a.z); val[6] = bflo(a.w); val[7] = bfhi(a.w);
                    val[8] = bflo(b2.x); val[9] = bfhi(b2.x); val[10] = bflo(b2.y); val[11] = bfhi(b2.y); val[12] = bflo(b2.z); val[13] = bfhi(b2.z); val[14] = bflo(b2.w); val[15] = bfhi(b2.w); }
                else if (srcf) {
#pragma unroll
                    for (int q = 0; q < 4; ++q) { const f32x4 v = ((const f32x4*)srcf)[q]; val[4 * q] = v.x; val[4 * q + 1] = v.y; val[4 * q + 2] = v.z; val[4 * q + 3] = v.w; } }
                else {
#pragma unroll
                    for (int e = 0; e < 16; ++e) val[e] = 0.f; }
                const f32x4* cw = (const f32x4*)(p.conv_w + (size_t)k * 1024 + ch0);
#pragma unroll
                for (int q = 0; q < 4; ++q) { const f32x4 wv = cw[q]; uc[4 * q] += wv.x * val[4 * q]; uc[4 * q + 1] += wv.y * val[4 * q + 1]; uc[4 * q + 2] += wv.z * val[4 * q + 2]; uc[4 * q + 3] += wv.w * val[4 * q + 3]; }
            }
            if (!rowvalid) {
#pragma unroll
                for (int e = 0; e < 16; ++e) uc[e] = 0.f; }
#pragma unroll
            for (int q = 0; q < 4; ++q) *(LAS f32x4*)(UCF + crow * 132 + 16 * cgp + 4 * q) = (f32x4){uc[4 * q], uc[4 * q + 1], uc[4 * q + 2], uc[4 * q + 3]};
            u32x4 o0, o1;
            o0.x = cvt_pk_bf16(uc[0], uc[1]); o0.y = cvt_pk_bf16(uc[2], uc[3]); o0.z = cvt_pk_bf16(uc[4], uc[5]); o0.w = cvt_pk_bf16(uc[6], uc[7]);
            o1.x = cvt_pk_bf16(uc[8], uc[9]); o1.y = cvt_pk_bf16(uc[10], uc[11]); o1.z = cvt_pk_bf16(uc[12], uc[13]); o1.w = cvt_pk_bf16(uc[14], uc[15]);
            *(LAS u32x4*)(UCB + crow * 272 + 32 * cgp) = o0; *(LAS u32x4*)(UCB + crow * 272 + 32 * cgp + 16) = o1;
        }
        __syncthreads();
        f32x4 accr[4], acci[4];
#pragma unroll
        for (int m = 0; m < 4; ++m) { accr[m] = (f32x4){0.f, 0.f, 0.f, 0.f}; acci[m] = (f32x4){0.f, 0.f, 0.f, 0.f}; }
#pragma unroll
        for (int m = 0; m < 4; ++m)
#pragma unroll
            for (int ks = 0; ks < 4; ++ks) { const bf16x8 af = *(const LAS bf16x8*)(UCB + (16 * m + fr) * 272 + 64 * ks + 16 * fq);
                accr[m] = mfma16(bw[0][ks], af, accr[m]); acci[m] = mfma16(bw[1][ks], af, acci[m]); }
        float a[4][4], bb[4][4];
#pragma unroll
        for (int m = 0; m < 4; ++m) {
            const int row = 16 * m + fr;
            const f32x4 ucv = *(const LAS f32x4*)(UCF + row * 132 + 16 * w + 4 * fq);
            const bool valid = sample || j > 0 || row < 16;
            const bool first = !sample && j == 0 && row == 0;
#pragma unroll
            for (int i = 0; i < 4; ++i) {
                const float r = fsig(accr[m][i] + rgb[i]), ig = fsig(acci[m][i] + igb[i]);
                const float la = -r * sp8[i];
                const float av = __expf(la);
                float mult = sqrtf(neg_expm1(2.0f * la));
                if (first) mult = 1.0f;
                a[m][i] = valid ? av : 1.0f; bb[m][i] = valid ? mult * ig * ucv[i] : 0.0f;
            }
        }
        if (!sample) {
#pragma unroll
            for (int m = 0; m < 4; ++m)
#pragma unroll
                for (int i = 0; i < 4; ++i)
#pragma unroll
                    for (int d = 1; d < 16; d <<= 1) { const float ap = __shfl_up(a[m][i], d, 16), bp = __shfl_up(bb[m][i], d, 16); if (fr >= d) { bb[m][i] = a[m][i] * bp + bb[m][i]; a[m][i] = a[m][i] * ap; } }
            float ca[4] = {1.f, 1.f, 1.f, 1.f}, cb[4] = {0.f, 0.f, 0.f, 0.f};
#pragma unroll
            for (int m = 0; m < 4; ++m)
#pragma unroll
                for (int i = 0; i < 4; ++i) { bb[m][i] = a[m][i] * cb[i] + bb[m][i]; a[m][i] = a[m][i] * ca[i]; ca[i] = __shfl(a[m][i], 15, 16); cb[i] = __shfl(bb[m][i], 15, 16); }
        } else {
#pragma unroll
            for (int m = 0; m < 4; ++m)
#pragma unroll
                for (int i = 0; i < 4; ++i)
#pragma unroll
                    for (int d = 1; d < 8; d <<= 1) { const float ap = __shfl_up(a[m][i], d, 8), bp = __shfl_up(bb[m][i], d, 8); if ((fr & 7) >= d) { bb[m][i] = a[m][i] * bp + bb[m][i]; a[m][i] = a[m][i] * ap; } }
        }
        if (!full) {
            if (fr == 15) { const size_t o = ((size_t)b * 33 + j) * 1024 + c0;
                *(f32x4*)(AGGA + o) = (f32x4){a[3][0], a[3][1], a[3][2], a[3][3]}; *(f32x4*)(AGGB + o) = (f32x4){bb[3][0], bb[3][1], bb[3][2], bb[3][3]}; }
        } else {
            f32x4 hin = (f32x4){0.f, 0.f, 0.f, 0.f};
            if (!sample) { for (int jj = 0; jj < j; ++jj) { const size_t o = ((size_t)b * 33 + jj) * 1024 + c0; const f32x4 A4 = *(const f32x4*)(AGGA + o), B4 = *(const f32x4*)(AGGB + o); hin = A4 * hin + B4; } }
#pragma unroll
            for (int m = 0; m < 4; ++m) {
                const int row = 16 * m + fr;
                size_t grow;
                if (sample) { const int db = 8 * st + (row >> 3); hin = *(const f32x4*)(p.state_rglru + (size_t)db * 1024 + c0); grow = (size_t)ROW_SAMPLE + 64 * st + row; }
                else grow = (size_t)b * 2048 + 64 * (j - 1) + row;
                f32x4 hv;
#pragma unroll
                for (int i = 0; i < 4; ++i) hv[i] = a[m][i] * hin[i] + bb[m][i];
                bf16_t* gp = GA + grow * 1024 + c0;
                const u32x2 g = *(const u32x2*)gp;
                u32x2 y; y.x = cvt_pk_bf16(hv[0] * bflo(g.x), hv[1] * bfhi(g.x)); y.y = cvt_pk_bf16(hv[2] * bflo(g.y), hv[3] * bfhi(g.y));
                *(u32x2*)gp = y;
                if (sample) { if ((fr & 7) == 7) { const int db = 8 * st + (row >> 3); *(f32x4*)(p.out + OFF_HS + (size_t)db * 1024 + c0) = hv; } }
                else if (j == 32 && m == 3 && fr == 15) *(f32x4*)(p.out + OFF_HP + (size_t)b * 1024 + c0) = hv;
            }
        }
        __syncthreads();
    }
}

__device__ __forceinline__ void hgrn_sample_item(const Params& p, LAS unsigned char* lds, int db, int h) {
    const int tid = threadIdx.x;
    unsigned char* ws = p.ws;
    const bf16_t* Qb = (const bf16_t*)(ws + WS_GRP0 + G_Q * GRP_BYTES); const bf16_t* LFb = (const bf16_t*)(ws + WS_GRP0 + G_LF * GRP_BYTES);
    bf16_t* Vb = (bf16_t*)(ws + WS_GRP0 + G_V * GRP_BYTES);
    LAS float* FF = (LAS float*)lds; LAS float* KK = FF + 1024; LAS float* QQ = KK + 1024; LAS float* VV = QQ + 1024; LAS float* ORED = VV + 1024;
    const size_t row0 = (size_t)ROW_SAMPLE + db * 8;
    {   const int k = tid & 127, tq = tid >> 7;
#pragma unroll
        for (int tt = 0; tt < 2; ++tt) { const int t = 2 * tq + tt; const size_t off = (row0 + t) * 1024 + h * 128 + k;
            const float fg = __expf(bf2f(LFb[off])); FF[k * 8 + t] = fg; KK[k * 8 + t] = 1.0f - fg; QQ[k * 8 + t] = bf2f(Qb[off]); VV[t * 128 + k] = bf2f(Vb[off]); }
    }
    const int kq = tid >> 5, v4 = tid & 31;
    __syncthreads();
    f32x4 O[8];
#pragma unroll
    for (int t = 0; t < 8; ++t) O[t] = (f32x4){0.f, 0.f, 0.f, 0.f};
    const size_t sbase = ((size_t)(db * 8 + h) * 128 + 8 * kq) * 128 + 4 * v4;
    const float* S0 = p.state_hgrn + sbase;
    float* S1 = p.out + OFF_SS + sbase;
    f32x4 S4[8];
#pragma unroll
    for (int kk = 0; kk < 8; ++kk) S4[kk] = *(const f32x4*)(S0 + kk * 128);
#pragma unroll 1
    for (int kk = 0; kk < 8; ++kk) {
        const int k = 8 * kq + kk;
        const f32x4 f0 = *(const LAS f32x4*)(FF + k * 8), f1 = *(const LAS f32x4*)(FF + k * 8 + 4), k0 = *(const LAS f32x4*)(KK + k * 8), k1 = *(const LAS f32x4*)(KK + k * 8 + 4),
                    q0 = *(const LAS f32x4*)(QQ + k * 8), q1 = *(const LAS f32x4*)(QQ + k * 8 + 4);
        f32x4 s = S4[0];
#pragma unroll
        for (int t = 0; t < 8; ++t) { const float ft = t < 4 ? f0[t & 3] : f1[t & 3], kt = t < 4 ? k0[t & 3] : k1[t & 3], qt = t < 4 ? q0[t & 3] : q1[t & 3];
            const f32x4 vt = *(const LAS f32x4*)(VV + t * 128 + 4 * v4);
            s = s * ft + vt * kt; O[t] += s * qt; }
        *(f32x4*)(S1 + kk * 128) = s;
#pragma unroll
        for (int r = 0; r < 7; ++r) S4[r] = S4[r + 1];
    }
#pragma unroll
    for (int t = 0; t < 8; ++t) *(LAS f32x4*)(ORED + (kq * 8 + t) * 128 + 4 * v4) = O[t];
    __syncthreads();
    {   const int t = tid >> 6, vp = tid & 63; float o0 = 0.f, o1 = 0.f;
#pragma unroll
        for (int g = 0; g < 16; ++g) { o0 += ORED[(g * 8 + t) * 128 + 2 * vp]; o1 += ORED[(g * 8 + t) * 128 + 2 * vp + 1]; }
        *(unsigned*)(Vb + (row0 + t) * 1024 + h * 128 + 2 * vp) = cvt_pk_bf16(o0, o1);
    }
    __syncthreads();
}

constexpr int HR_QR = 0, HR_LFT = 8704, HR_VR = 18944, HR_SIZE = 27648;
constexpr int HO_QM = 0, HO_KM = 8704, HO_KMT = 17408, HO_VT = 27648, HO_E1 = 37888, HO_E2 = 38400, HO_SIZE = 38912;
constexpr int HC_RAW = 0, HC_OPS = 2 * HR_SIZE;
static_assert(HC_OPS + 2 * HO_SIZE <= 147456 - 64, "hgrn chain LDS map");
__device__ __forceinline__ void hgrn_chain(const Params& p, LAS unsigned char* lds, int b, int h) {
    const int tid = threadIdx.x, lane = tid & 63, w = __builtin_amdgcn_readfirstlane(tid >> 6), fr = lane & 15, fq = lane >> 4;
    unsigned char* ws = p.ws;
    const bf16_t* Qb = (const bf16_t*)(ws + WS_GRP0 + G_Q * GRP_BYTES); const bf16_t* LFb = (const bf16_t*)(ws + WS_GRP0 + G_LF * GRP_BYTES);
    bf16_t* Vb = (bf16_t*)(ws + WS_GRP0 + G_V * GRP_BYTES);
    const int gt = tid >> 4, gc = tid & 15;
    const int kk0 = 16 * w + fr;
    const int kperm = 32 * (w >> 1) + 8 * (fr >> 2) + 4 * (w & 1) + (fr & 3);
    bf16x8 Lf0, Lf1;
    {   union { unsigned short s[8]; bf16x8 v; } l0, l1;
#pragma unroll
        for (int j = 0; j < 8; ++j) { l0.s[j] = (8 * fq + j <= fr) ? 0x3f80 : 0; l1.s[j] = (8 * fq + j <= 16 + fr) ? 0x3f80 : 0; }
        Lf0 = l0.v; Lf1 = l1.v; }
    f32x4 S[8];
#pragma unroll
    for (int kt = 0; kt < 8; ++kt) S[kt] = (f32x4){0.f, 0.f, 0.f, 0.f};
    u32x4 ldq, ldf, ldv;
#define HC_ROW0(n) ((n) == 0 ? (size_t)ROW_META : (size_t)b * 2048 + 32 * ((n) - 1))
#define HC_G(n) do { const int n_ = (n); if (gt < (n_ == 0 ? 16 : 32)) { const size_t off_ = (HC_ROW0(n_) + gt) * 1024 + h * 128 + 8 * gc; \
        ldq = *(const u32x4*)(Qb + off_); ldf = *(const u32x4*)(LFb + off_); ldv = *(const u32x4*)(Vb + off_); } \
        else { ldq = (u32x4){0u, 0u, 0u, 0u}; ldf = ldq; ldv = ldq; } } while (0)
#define HC_W(n) do { LAS unsigned char* raw_ = lds + HC_RAW + ((n) & 1) * HR_SIZE; \
        *(LAS u32x4*)(raw_ + HR_QR + gt * 272 + 16 * gc) = ldq; *(LAS u32x4*)(raw_ + HR_VR + gt * 272 + 16 * gc) = ldv; \
        LAS bf16_t* lft_ = (LAS bf16_t*)(raw_ + HR_LFT) + (8 * gc) * 40 + gt; \
        lft_[0] = (bf16_t)(ldf.x & 0xffffu); lft_[40] = (bf16_t)(ldf.x >> 16); lft_[80] = (bf16_t)(ldf.y & 0xffffu); lft_[120] = (bf16_t)(ldf.y >> 16); \
        lft_[160] = (bf16_t)(ldf.z & 0xffffu); lft_[200] = (bf16_t)(ldf.z >> 16); lft_[240] = (bf16_t)(ldf.w & 0xffffu); lft_[280] = (bf16_t)(ldf.w >> 16); } while (0)
#define HC_P(n) do { LAS unsigned char* raw_ = lds + HC_RAW + ((n) & 1) * HR_SIZE; LAS unsigned char* ops_ = lds + HC_OPS + ((n) & 1) * HO_SIZE; \
        const LAS bf16_t* LFT_ = (const LAS bf16_t*)(raw_ + HR_LFT); const LAS bf16_t* QR_ = (const LAS bf16_t*)(raw_ + HR_QR); const LAS bf16_t* VR_ = (const LAS bf16_t*)(raw_ + HR_VR); \
        const bf16x8 lfT_ = *(const LAS bf16x8*)(LFT_ + kk0 * 40 + 8 * fq); \
        const f32x4 z_ = (f32x4){0.f, 0.f, 0.f, 0.f}; \
        f32x4 bc_[2]; bc_[0] = mfma16(Lf0, lfT_, z_); bc_[1] = mfma16(Lf1, lfT_, z_); \
        const float b15_ = __shfl(bc_[0][3], 48 + fr), b31_ = __shfl(bc_[1][3], 48 + fr); \
        _Pragma("unroll") for (int tt_ = 0; tt_ < 2; ++tt_) { \
            const u32x2 lfw_ = *(const LAS u32x2*)(LFT_ + kk0 * 40 + 16 * tt_ + 4 * fq); \
            float lfv_[4]; lfv_[0] = bflo(lfw_.x); lfv_[1] = bfhi(lfw_.x); lfv_[2] = bflo(lfw_.y); lfv_[3] = bfhi(lfw_.y); \
            float kmv_[4], vvv_[4]; \
            _Pragma("unroll") for (int i_ = 0; i_ < 4; ++i_) { const int t_ = 16 * tt_ + 4 * fq + i_; \
                const float q_ = bf2f(QR_[t_ * 136 + kk0]); vvv_[i_] = bf2f(VR_[t_ * 136 + kk0]); const float bt_ = bc_[tt_][i_]; \
                const float qm_ = q_ * __expf(bt_ - b15_); kmv_[i_] = (1.0f - __expf(lfv_[i_])) * __expf(b15_ - bt_); \
                const bf16_t kmb_ = f2bf(kmv_[i_]); \
                ((LAS bf16_t*)(ops_ + HO_QM))[t_ * 136 + kperm] = f2bf(qm_); ((LAS bf16_t*)(ops_ + HO_KM))[t_ * 136 + kperm] = kmb_; } \
            u32x2 kw_, vw_; kw_.x = cvt_pk_bf16(kmv_[0], kmv_[1]); kw_.y = cvt_pk_bf16(kmv_[2], kmv_[3]); vw_.x = cvt_pk_bf16(vvv_[0], vvv_[1]); vw_.y = cvt_pk_bf16(vvv_[2], vvv_[3]); \
            *(LAS u32x2*)((LAS bf16_t*)(ops_ + HO_KMT) + kk0 * 40 + 16 * tt_ + 4 * fq) = kw_; *(LAS u32x2*)((LAS bf16_t*)(ops_ + HO_VT) + kk0 * 40 + 16 * tt_ + 4 * fq) = vw_; } \
        if (fq == 0) { ((LAS float*)(ops_ + HO_E1))[kk0] = __expf(b15_); ((LAS float*)(ops_ + HO_E2))[kk0] = __expf(b31_ - b15_); } } while (0)
    HC_G(0); HC_W(0); HC_G(1);
    __syncthreads();
    HC_P(0); HC_W(1); HC_G(2);
    __syncthreads();
    for (int c = 0; c < 65; ++c) {
        const size_t row0 = HC_ROW0(c);
        LAS unsigned char* ops = lds + HC_OPS + (c & 1) * HO_SIZE;
        const LAS bf16_t* QM = (const LAS bf16_t*)(ops + HO_QM); const LAS bf16_t* KM = (const LAS bf16_t*)(ops + HO_KM); const LAS bf16_t* KMT = (const LAS bf16_t*)(ops + HO_KMT);
        const LAS bf16_t* VT = (const LAS bf16_t*)(ops + HO_VT); const LAS float* E1 = (const LAS float*)(ops + HO_E1); const LAS float* E2 = (const LAS float*)(ops + HO_E2);
#pragma unroll
        for (int kt = 0; kt < 8; ++kt) { const f32x4 e = *(const LAS f32x4*)(E1 + 16 * kt + 4 * fq); S[kt] = S[kt] * e; }
        bf16x8 qf[2][4], kf[2][4];
#pragma unroll
        for (int mt = 0; mt < 2; ++mt)
#pragma unroll
            for (int ks = 0; ks < 4; ++ks) { qf[mt][ks] = *(const LAS bf16x8*)(QM + (16 * mt + fr) * 136 + 32 * ks + 8 * fq); kf[mt][ks] = *(const LAS bf16x8*)(KM + (16 * mt + fr) * 136 + 32 * ks + 8 * fq); }
        f32x4 a00 = (f32x4){0.f, 0.f, 0.f, 0.f}, a10 = a00, a11 = a00;
#pragma unroll
        for (int ks = 0; ks < 4; ++ks) { a00 = mfma16(kf[0][ks], qf[0][ks], a00); a10 = mfma16(kf[0][ks], qf[1][ks], a10); a11 = mfma16(kf[1][ks], qf[1][ks], a11); }
#pragma unroll
        for (int i = 0; i < 4; ++i) { if (4 * fq + i > fr) { a00[i] = 0.f; a11[i] = 0.f; } }
        bf16x8 aop0, aop1;
        {   union { u32x4 u; bf16x8 v; } c0, c1;
            c0.u.x = cvt_pk_bf16(a00[0], a00[1]); c0.u.y = cvt_pk_bf16(a00[2], a00[3]); c0.u.z = 0u; c0.u.w = 0u;
            c1.u.x = cvt_pk_bf16(a10[0], a10[1]); c1.u.y = cvt_pk_bf16(a10[2], a10[3]); c1.u.z = cvt_pk_bf16(a11[0], a11[1]); c1.u.w = cvt_pk_bf16(a11[2], a11[3]);
            aop0 = c0.v; aop1 = c1.v; }
        f32x4 o0 = (f32x4){0.f, 0.f, 0.f, 0.f}, o1 = o0;
#pragma unroll
        for (int ks = 0; ks < 4; ++ks) { union { u32x4 u; bf16x8 v; } sf;
            sf.u.x = cvt_pk_bf16(S[2 * ks][0], S[2 * ks][1]); sf.u.y = cvt_pk_bf16(S[2 * ks][2], S[2 * ks][3]); sf.u.z = cvt_pk_bf16(S[2 * ks + 1][0], S[2 * ks + 1][1]); sf.u.w = cvt_pk_bf16(S[2 * ks + 1][2], S[2 * ks + 1][3]);
            o0 = mfma16(sf.v, qf[0][ks], o0); o1 = mfma16(sf.v, qf[1][ks], o1); }
        {   union { u32x4 u; bf16x8 v; } vs;
            const u32x2 lo = *(const LAS u32x2*)(VT + (16 * w + fr) * 40 + 4 * fq), hi = *(const LAS u32x2*)(VT + (16 * w + fr) * 40 + 16 + 4 * fq);
            vs.u.x = lo.x; vs.u.y = lo.y; vs.u.z = hi.x; vs.u.w = hi.y;
            o0 = mfma16(vs.v, aop0, o0); o1 = mfma16(vs.v, aop1, o1); }
        if (c > 0) {
            u32x2 y0, y1; y0.x = cvt_pk_bf16(o0[0], o0[1]); y0.y = cvt_pk_bf16(o0[2], o0[3]); y1.x = cvt_pk_bf16(o1[0], o1[1]); y1.y = cvt_pk_bf16(o1[2], o1[3]);
            *(u32x2*)(Vb + (row0 + fr) * 1024 + h * 128 + 16 * w + 4 * fq) = y0; *(u32x2*)(Vb + (row0 + 16 + fr) * 1024 + h * 128 + 16 * w + 4 * fq) = y1; }
        {   const bf16x8 vn = *(const LAS bf16x8*)(VT + (16 * w + fr) * 40 + 8 * fq);
#pragma unroll
            for (int kt = 0; kt < 8; ++kt) { const bf16x8 kmt = *(const LAS bf16x8*)(KMT + (16 * kt + fr) * 40 + 8 * fq); S[kt] = mfma16(kmt, vn, S[kt]);
                const f32x4 e = *(const LAS f32x4*)(E2 + 16 * kt + 4 * fq); S[kt] = S[kt] * e; } }
        if (c + 1 < 65) HC_P(c + 1);
        if (c + 2 < 65) HC_W(c + 2);
        if (c + 3 < 65) HC_G(c + 3);
        __syncthreads();
    }
#undef HC_ROW0
#undef HC_G
#undef HC_W
#undef HC_P
    float* SP = p.out + OFF_SP + ((size_t)(b * 8 + h) * 128) * 128;
#pragma unroll
    for (int kt = 0; kt < 8; ++kt)
#pragma unroll
        for (int i = 0; i < 4; ++i) SP[(size_t)(16 * kt + 4 * fq + i) * 128 + 16 * w + fr] = S[kt][i];
}

__device__ __forceinline__ void p2c_finish(const Params& p) {
    const int tid = threadIdx.x, lane = tid & 63, wave = tid >> 6;
    const int gw = blockIdx.x * NWAVES + wave, NGW = gridDim.x * NWAVES;
    unsigned char* ws = p.ws;
    const bf16_t* Vb = (const bf16_t*)(ws + WS_GRP0 + G_V * GRP_BYTES); bf16_t* OG = (bf16_t*)(ws + WS_GRP0 + G_OG * GRP_BYTES);
    const bf16_t* U = (const bf16_t*)(ws + WS_GRP0 + G_U * GRP_BYTES);
    float gn[16];
#pragma unroll
    for (int q = 0; q < 4; ++q) { const f32x4 v = *(const f32x4*)(p.gnorm + 16 * lane + 4 * q); gn[4 * q] = v.x; gn[4 * q + 1] = v.y; gn[4 * q + 2] = v.z; gn[4 * q + 3] = v.w; }
    for (int m = gw; m < M_MAIN; m += NGW) {
        const u32x4* op = (const u32x4*)(Vb + (size_t)m * 1024 + 16 * lane); u32x4* gp = (u32x4*)(OG + (size_t)m * 1024 + 16 * lane);
        const u32x4 oa = op[0], ob = op[1], ga = gp[0], gb = gp[1];
        float o[16], g[16];
        o[0] = bflo(oa.x); o[1] = bfhi(oa.x); o[2] = bflo(oa.y); o[3] = bfhi(oa.y); o[4] = bflo(oa.z); o[5] = bfhi(oa.z); o[6] = bflo(oa.w); o[7] = bfhi(oa.w);
        o[8] = bflo(ob.x); o[9] = bfhi(ob.x); o[10] = bflo(ob.y); o[11] = bfhi(ob.y); o[12] = bflo(ob.z); o[13] = bfhi(ob.z); o[14] = bflo(ob.w); o[15] = bfhi(ob.w);
        g[0] = bflo(ga.x); g[1] = bfhi(ga.x); g[2] = bflo(ga.y); g[3] = bfhi(ga.y); g[4] = bflo(ga.z); g[5] = bfhi(ga.z); g[6] = bflo(ga.w); g[7] = bfhi(ga.w);
        g[8] = bflo(gb.x); g[9] = bfhi(gb.x); g[10] = bflo(gb.y); g[11] = bfhi(gb.y); g[12] = bflo(gb.z); g[13] = bfhi(gb.z); g[14] = bflo(gb.w); g[15] = bfhi(gb.w);
        float ss = 0.f;
#pragma unroll
        for (int e = 0; e < 16; ++e) ss += o[e] * o[e];
        ss += __shfl_xor(ss, 1); ss += __shfl_xor(ss, 2); ss += __shfl_xor(ss, 4);
        const float rstd = 1.0f / sqrtf(ss * (1.0f / 128.0f) + EPS);
        float y[16];
#pragma unroll
        for (int e = 0; e < 16; ++e) y[e] = o[e] * rstd * gn[e] * g[e];
        u32x4 ya, yb;
        ya.x = cvt_pk_bf16(y[0], y[1]); ya.y = cvt_pk_bf16(y[2], y[3]); ya.z = cvt_pk_bf16(y[4], y[5]); ya.w = cvt_pk_bf16(y[6], y[7]);
        yb.x = cvt_pk_bf16(y[8], y[9]); yb.y = cvt_pk_bf16(y[10], y[11]); yb.z = cvt_pk_bf16(y[12], y[13]); yb.w = cvt_pk_bf16(y[14], y[15]);
        gp[0] = ya; gp[1] = yb;
    }
    const int gt = blockIdx.x * NTHREADS + tid, NGT = gridDim.x * NTHREADS;
    for (int e = gt; e < (NB + DBATCH) * 3 * 1024; e += NGT) {
        const int c = e & 1023, rk = e >> 10, sq = rk / 3, kk = rk % 3;
        if (sq < NB) p.out[OFF_CONVP + (size_t)(sq * 3 + kk) * 1024 + c] = bf2f(U[((size_t)sq * 2048 + 2045 + kk) * 1024 + c]);
        else { const int db = sq - NB; p.out[OFF_CONVS + (size_t)(db * 3 + kk) * 1024 + c] = bf2f(U[((size_t)ROW_SAMPLE + db * 8 + 5 + kk) * 1024 + c]); }
    }
}

__device__ __forceinline__ void p4b_rows(const Params& p) {
    const int tid = threadIdx.x, lane = tid & 63, wave = tid >> 6;
    const int gw = blockIdx.x * NWAVES + wave, NGW = gridDim.x * NWAVES;
    const float* MO = (const float*)(p.ws + WS_GRP0 + G_LF * GRP_BYTES);
    bf16_t* HN = (bf16_t*)(p.ws + WS_GRP0 + G_U * GRP_BYTES);
    const f32x4* g1 = (const f32x4*)(p.gains + 1024) + lane; const f32x4* g2 = (const f32x4*)(p.gains + 2048) + lane;
    for (int m = gw; m < M_MAIN; m += NGW) {
        const float* xrow = m < ROW_SAMPLE ? p.x_prompt + (size_t)m * D : p.x_sample + (size_t)(m - ROW_SAMPLE) * D;
        const f32x4* mr = (const f32x4*)(MO + (size_t)m * D) + lane; const f32x4* xr = (const f32x4*)xrow + lane;
        f32x4 v[4], x[4]; float s = 0.f;
#pragma unroll
        for (int j = 0; j < 4; ++j) { v[j] = mr[64 * j]; x[j] = xr[64 * j]; s += (v[j].x * v[j].x + v[j].y * v[j].y) + (v[j].z * v[j].z + v[j].w * v[j].w); }
        const float rstd = 1.0f / sqrtf(wave_sum(s) * (1.f / D) + EPS);
        float s2 = 0.f;
        f32x4* orow = (f32x4*)(p.out + OFF_Y + (size_t)m * D) + lane;
#pragma unroll
        for (int j = 0; j < 4; ++j) { const f32x4 gg = g1[64 * j]; x[j] = x[j] + v[j] * rstd * gg; orow[64 * j] = x[j]; s2 += (x[j].x * x[j].x + x[j].y * x[j].y) + (x[j].z * x[j].z + x[j].w * x[j].w); }
        const float rstd2 = 1.0f / sqrtf(wave_sum(s2) * (1.f / D) + EPS);
        u32x2* o8 = (u32x2*)(HN + (size_t)m * D) + lane;
#pragma unroll
        for (int j = 0; j < 4; ++j) { const f32x4 gg = g2[64 * j]; u32x2 wv; wv.x = cvt_pk_bf16(x[j].x * rstd2 * gg.x, x[j].y * rstd2 * gg.y); wv.y = cvt_pk_bf16(x[j].z * rstd2 * gg.z, x[j].w * rstd2 * gg.w); o8[64 * j] = wv; }
    }
}
__device__ __forceinline__ void p7_rows(const Params& p) {
    const int tid = threadIdx.x, lane = tid & 63, wave = tid >> 6;
    const int gw = blockIdx.x * NWAVES + wave, NGW = gridDim.x * NWAVES;
    const float* FFB = (const float*)(p.ws + WS_GRP0 + G_U * GRP_BYTES);
    const f32x4* g3 = (const f32x4*)(p.gains + 3072) + lane;
    for (int m = gw; m < M_MAIN; m += NGW) {
        const f32x4* fr_ = (const f32x4*)(FFB + (size_t)m * D) + lane;
        f32x4* orow = (f32x4*)(p.out + OFF_Y + (size_t)m * D) + lane;
        f32x4 v[4], x[4]; float s = 0.f;
#pragma unroll
        for (int j = 0; j < 4; ++j) { v[j] = fr_[64 * j]; x[j] = orow[64 * j]; s += (v[j].x * v[j].x + v[j].y * v[j].y) + (v[j].z * v[j].z + v[j].w * v[j].w); }
        const float rstd = 1.0f / sqrtf(wave_sum(s) * (1.f / D) + EPS);
#pragma unroll
        for (int j = 0; j < 4; ++j) { const f32x4 gg = g3[64 * j]; f32x4 r = x[j] + v[j] * rstd * gg;
#ifdef SANITIZE
#pragma unroll
            for (int e = 0; e < 4; ++e) if (!(fabsf(r[e]) < 1e30f)) r[e] = 1000.0f;
#endif
            orow[64 * j] = r; }
    }
}

__global__ void __launch_bounds__(NTHREADS, 2) fwd(Params p) {
    extern __shared__ __attribute__((aligned(16))) unsigned char lds_raw[];
    LAS unsigned char* lds = (LAS unsigned char*)lds_raw;
    unsigned char* ws = p.ws;
    const int G = gridDim.x, bid = blockIdx.x;
#ifndef PHMASK
#define PHMASK 0xFFF
#endif
#define IN(k) (((PHMASK >> (k)) & 1) && p.ph_lo <= (k) && (k) < p.ph_hi)
#ifndef REPEAT_MASK
#define REPEAT_MASK 0
#endif
#define REPS(k) ((((REPEAT_MASK) >> (k)) & 1) ? 2 : 1)
#ifndef CG_SEAMS
#define CG_SEAMS 0x001
#endif
#define SEAM(k) do { if (p.use_bar && IN(k) && IN((k) + 1)) { if ((CG_SEAMS >> (k)) & 1) cg::this_grid().sync(); else xcd_barrier(bar); } } while (0)
    XcdBarrier bar; bar.bar = (unsigned*)(ws + WS_CTL) + 4096; bar.x = 0; bar.st = nullptr;
    if (p.use_bar) {
        volatile LAS unsigned* st = (volatile LAS unsigned*)(lds + LDS_BYTES - 64);
        if (threadIdx.x < 16) st[threadIdx.x] = 0u;
        __syncthreads();
        bar = xcd_barrier_post((unsigned*)(ws + WS_CTL) + 4096, st);
    }
    bf16_t* GRP[6];
#pragma unroll
    for (int g = 0; g < 6; ++g) GRP[g] = (bf16_t*)(ws + WS_GRP0 + (size_t)g * GRP_BYTES);

    if (IN(0)) for (int rep_ = 0; rep_ < REPS(0); ++rep_) p0_prologue(p, lds);
    SEAM(0);
    if (IN(1)) for (int rep_ = 0; rep_ < REPS(1); ++rep_) {
        pg8::Gemm g{(const bf16_t*)((unsigned char*)p.out + OFF_SS * 4), (const bf16_t*)(ws + WS_WIN), M_PAD, DIN, D};
        pg8::StaticOrder S; S.init(M_PAD, DIN, G, bid);
        pg8::EpiProj E{ws, (unsigned char*)p.out, p.hgrn_lb};
        pg8::gemm_phase<pg8::EpiProj, pg8::StaticOrder, true, true>(lds, g, S, E);
    }
    SEAM(1);
    if (IN(2)) {
        rg_phase(p, lds, 0, bid, G);
    }
    SEAM(2);
    if (IN(3)) {
        if (bid < 64) hgrn_chain(p, lds, bid >> 3, bid & 7);
        else {
            for (int it = bid - 64; it < DBATCH * 8; it += G - 64) hgrn_sample_item(p, lds, it >> 3, it & 7);
            rg_phase(p, lds, 1, bid - 64, G - 64);
        }
    }
    SEAM(3);
    if (IN(4)) p2c_finish(p);
    SEAM(4);
    if (IN(5)) for (int rep_ = 0; rep_ < REPS(5); ++rep_) {
        pg8::Gemm g{GRP[G_GA], (const bf16_t*)(ws + WS_WA), M_MAIN, D, D};
        pg8::StaticOrder S; S.init(M_MAIN, D, G, bid);
        pg8::EpiGate<0> E{(const bf16_t*)p.out, nullptr, GRP[G_U]};
        pg8::gemm_phase<pg8::EpiGate<0>, pg8::StaticOrder, true, true>(lds, g, S, E);
    }
    SEAM(5);
    if (IN(6)) for (int rep_ = 0; rep_ < REPS(6); ++rep_) {
        pg8::Gemm g{GRP[G_OG], (const bf16_t*)(ws + WS_WB), M_MAIN, D, D};
        pg8::StaticOrder S; S.init(M_MAIN, D, G, bid);
        pg8::EpiGate<1> E{(const bf16_t*)((unsigned char*)p.out + GATE_BYTES), GRP[G_U], GRP[G_Q]};
        pg8::gemm_phase<pg8::EpiGate<1>, pg8::StaticOrder, true, true>(lds, g, S, E);
    }
    SEAM(6);
    if (IN(7)) for (int rep_ = 0; rep_ < REPS(7); ++rep_) {
        pg8::Gemm g{GRP[G_Q], (const bf16_t*)(ws + WS_WOUT), M_MAIN, D, D};
        pg8::StaticOrder S; S.init(M_MAIN, D, G, bid);
        pg8::EpiF32 E{(float*)GRP[G_LF]};
        pg8::gemm_phase<pg8::EpiF32, pg8::StaticOrder, true, true>(lds, g, S, E);
    }
    SEAM(7);
    if (IN(8)) for (int rep_ = 0; rep_ < REPS(8); ++rep_) p4b_rows(p);
    SEAM(8);
    if (IN(9)) for (int rep_ = 0; rep_ < REPS(9); ++rep_) {
        pg8::Gemm g{GRP[G_U], (const bf16_t*)(ws + WS_WUP), M_MAIN, DFF, D};
        pg8::StaticOrder S; S.init(M_MAIN, DFF, G, bid);
        pg8::EpiRelu2 E{GRP[G_Q]};
        pg8::gemm_phase<pg8::EpiRelu2, pg8::StaticOrder, true, true>(lds, g, S, E);
    }
    SEAM(9);
    if (IN(10)) for (int rep_ = 0; rep_ < REPS(10); ++rep_) {
        pg8::Gemm g{GRP[G_Q], (const bf16_t*)(ws + WS_WDN), M_MAIN, D, DFF};
        pg8::StaticOrder S; S.init(M_MAIN, D, G, bid);
        pg8::EpiF32 E{(float*)GRP[G_U]};
        pg8::gemm_phase<pg8::EpiF32, pg8::StaticOrder, true, true>(lds, g, S, E);
    }
    SEAM(10);
    if (IN(11)) p7_rows(p);
#undef IN
#undef SEAM
}

#ifndef N_LAUNCH_MODE
#define N_LAUNCH_MODE 1
#endif
extern "C" void kernel_launch(void* const* d_in, const int* in_sizes, int n_in, void* d_out, int out_size, void* d_ws, size_t ws_size, hipStream_t stream) {
    static int grid = 0;
    if (grid == 0) {
        if (n_in != 22 || (size_t)out_size != OUT_FLOATS || ws_size < WS_END) { fprintf(stderr, "kernel_launch: unexpected sizes (n_in %d, out %d, ws %zu); nothing launched\n", n_in, out_size, ws_size); grid = -1; return; }
        int dev = 0, cus = 0, per_cu = 0;
        if (hipGetDevice(&dev) != hipSuccess || hipDeviceGetAttribute(&cus, hipDeviceAttributeMultiprocessorCount, dev) != hipSuccess) { grid = -1; return; }
        if (hipFuncSetAttribute((const void*)fwd, hipFuncAttributeMaxDynamicSharedMemorySize, LDS_BYTES) != hipSuccess) { fprintf(stderr, "kernel_launch: hipFuncSetAttribute failed\n"); grid = -1; return; }
        if (hipOccupancyMaxActiveBlocksPerMultiprocessor(&per_cu, (const void*)fwd, NTHREADS, LDS_BYTES) != hipSuccess || per_cu < 1) { fprintf(stderr, "kernel_launch: occupancy query failed (%d)\n", per_cu); (void)hipGetLastError(); grid = -1; return; }
        grid = cus;
        if (grid != 256) fprintf(stderr, "kernel_launch: %d CUs; this kernel is laid out for 256\n", grid);
    }
    if (grid < 0) return;
    (void)hipMemsetAsync((char*)d_ws + WS_CTL, 0, CTL_ZERO_BYTES, stream);
    Params p{};
    const float** pp = (const float**)&p;
    for (int i = 0; i < 22; ++i) pp[i] = (const float*)d_in[i];
    p.out = (float*)d_out; p.ws = (unsigned char*)d_ws;
#if N_LAUNCH_MODE == 1
    p.ph_lo = 0; p.ph_hi = NPHASES; p.use_bar = 1;
    void* args[] = {&p};
    hipError_t e = hipLaunchCooperativeKernel((const void*)fwd, dim3(grid), dim3(NTHREADS), args, LDS_BYTES, stream);
    if (e != hipSuccess) fprintf(stderr, "kernel_launch: cooperative launch failed: %s (grid %d)\n", hipGetErrorString(e), grid);
#else
#ifndef NPH_RUN
#define NPH_RUN NPHASES
#endif
    for (int ph = 0; ph < NPH_RUN; ++ph) {
        p.ph_lo = ph; p.ph_hi = ph + 1; p.use_bar = 0;
        hipLaunchKernelGGL(fwd, dim3(grid), dim3(NTHREADS), LDS_BYTES, stream, p);
    }
#ifdef DUMP_V
    (void)hipMemcpyAsync((char*)d_out, (char*)d_ws + WS_GRP0 + G_V * GRP_BYTES, GATE_BYTES, hipMemcpyDeviceToDevice, stream);
    (void)hipMemcpyAsync((char*)d_out + GATE_BYTES, (char*)d_ws + WS_GRP0 + G_V * GRP_BYTES, GATE_BYTES, hipMemcpyDeviceToDevice, stream);
#endif
#ifdef DUMP_YAB
    (void)hipMemcpyAsync((char*)d_out, (char*)d_ws + WS_GRP0 + G_GA * GRP_BYTES, GATE_BYTES, hipMemcpyDeviceToDevice, stream);
    (void)hipMemcpyAsync((char*)d_out + GATE_BYTES, (char*)d_ws + WS_GRP0 + G_OG * GRP_BYTES, GATE_BYTES, hipMemcpyDeviceToDevice, stream);
#endif
#ifdef DUMP_YA
    (void)hipMemcpyAsync((char*)d_out, (char*)d_ws + WS_GRP0 + G_GA * GRP_BYTES, GATE_BYTES, hipMemcpyDeviceToDevice, stream);
    (void)hipMemcpyAsync((char*)d_out + GATE_BYTES, (char*)d_ws + WS_GRP0 + G_GA * GRP_BYTES, GATE_BYTES, hipMemcpyDeviceToDevice, stream);
#endif
#endif
}
```

```cpp
#include <hip/hip_runtime.h>
#include <hip/hip_cooperative_groups.h>
#include <cstdio>
#include <cstdint>
namespace cg = cooperative_groups;

constexpr int D = 1024, NB = 8, SEQ = 2048, NMETA = 16, DBATCH = 128, DSEQ = 8, DIN = 8192, DFF = 4096;
constexpr int ROW_SAMPLE = NB * SEQ;
constexpr int M_MAIN = ROW_SAMPLE + DBATCH * DSEQ;
constexpr int ROW_META = M_MAIN;
constexpr int M_REAL = M_MAIN + NMETA;
constexpr int M_PAD = 17664;
constexpr float EPS = 1e-6f;

constexpr size_t MiB = 1u << 20;
constexpr size_t WS_CTL = 0, CTL_ZERO_BYTES = 1 * MiB;
constexpr size_t WS_WIN = 1 * MiB, WS_WUP = 17 * MiB, WS_WDN = 25 * MiB, WS_WA = 33 * MiB, WS_WB = 35 * MiB, WS_WOUT = 37 * MiB, WS_WRG = 39 * MiB;
constexpr size_t AGG_BYTES = (size_t)NB * 33 * 1024 * 4;
constexpr size_t WS_AGGA = 39 * MiB + 512 * 1024, WS_AGGB = WS_AGGA + AGG_BYTES;
constexpr size_t GRP_BYTES = (size_t)M_PAD * 1024 * 2;
constexpr size_t WS_GRP0 = 42 * MiB;
constexpr size_t WS_END = WS_GRP0 + 6 * GRP_BYTES;
static_assert(WS_AGGB + AGG_BYTES <= WS_GRP0 && WS_END <= 256 * MiB, "d_ws map");
constexpr int G_U = 0, G_GA = 1, G_Q = 2, G_LF = 3, G_V = 4, G_OG = 5;
constexpr size_t OFF_Y = 0, OFF_CONVP = 17825792, OFF_HP = 17850368, OFF_SP = 17858560, OFF_CONVS = 18907136, OFF_HS = 19300352, OFF_SS = 19431424, OUT_FLOATS = 36208640;
constexpr size_t GATE_BYTES = (size_t)M_MAIN * 1024 * 2;
static_assert(2 * GATE_BYTES == OFF_CONVP * 4, "gates fill the y region exactly");
#define N_LAUNCH_MODE 1
namespace pg8 {
#define PG8_LAS __attribute__((address_space(3)))
typedef unsigned short bf16_t;
typedef short bf16x8 __attribute__((ext_vector_type(8)));
typedef float f32x4 __attribute__((ext_vector_type(4)));
typedef unsigned u32x4 __attribute__((ext_vector_type(4)));
constexpr int BM = 256, BK = 64, HALF = 128, HTB = HALF * BK * 2  , STAGE_BYTES = 8 * HTB, NXCD = 8, WGM = 8;

__host__ __device__ __forceinline__ int lds_byte(int r, int c) { const int st = (r >> 4) * 2 + (c >> 5), rr = r & 15, cc = c & 31, ob = rr * 64 + cc * 2; return st * 1024 + (ob ^ (((ob >> 9) & 1) << 5)); }
__host__ __device__ __forceinline__ void stage_rc(int b, int& R, int& C) { const int st = b / 1024, sb = b % 1024, swz = sb ^ (((sb >> 9) & 1) << 5); R = (st >> 1) * 16 + swz / 64; C = (st & 1) * 32 + (swz % 64) / 2; }
__host__ __device__ __forceinline__ int perm32(int rho) { const int n = rho >> 4, i = rho & 15; return 8 * (i >> 2) + 4 * n + (i & 3); }

struct Unit { int pm, pn; };
struct Gemm { const bf16_t* A; const bf16_t* Bt; int M, N, K; };

struct StaticOrder {
    int nM, nN, nwg, G, c;
    __host__ __device__ void init(int M, int N, int G_, int c_) { nM = M / BM; nN = N / BM; nwg = nM * nN; G = G_; c = c_; }
    __host__ __device__ bool next(int i, Unit& u) const {
        const long L = (long)i * G + c; if (L >= nwg) return false;
        int wgid = (int)L; { const int q = nwg / NXCD, r = nwg % NXCD, xcd = wgid % NXCD, off = wgid / NXCD; wgid = (xcd < r ? xcd * (q + 1) : r * (q + 1) + (xcd - r) * q) + off; }
        const int nig = WGM * nN, gid = wgid / nig, fm = gid * WGM, gsz = (nM - fm) < WGM ? (nM - fm) : WGM;
        u.pm = fm + ((wgid % nig) % gsz); u.pn = (wgid % nig) / gsz; return true;
    }
    __device__ __forceinline__ void a_ready(const Unit&) const {}
    __device__ __forceinline__ void done(const Unit&) const {}
};

typedef __bf16 bf16x2n __attribute__((ext_vector_type(2)));
typedef float f32x2n __attribute__((ext_vector_type(2)));
__device__ __forceinline__ unsigned cvt_pk_bf16(float lo, float hi) { const f32x2n v = {lo, hi}; const bf16x2n r = __builtin_convertvector(v, bf16x2n); return __builtin_bit_cast(unsigned, r); }
typedef float f32x2 __attribute__((ext_vector_type(2)));

__device__ __forceinline__ float fsig(float x) { return __builtin_amdgcn_rcpf(1.0f + __expf(-x)); }
__device__ __forceinline__ u32x4 pack8(const f32x4 a, const f32x4 b) { u32x4 w; w.x = cvt_pk_bf16(a[0], a[1]); w.y = cvt_pk_bf16(a[2], a[3]); w.z = cvt_pk_bf16(b[0], b[1]); w.w = cvt_pk_bf16(b[2], b[3]); return w; }
__device__ __forceinline__ float bf_lo(unsigned w) { return __uint_as_float(w << 16); }
__device__ __forceinline__ float bf_hi(unsigned w) { return __uint_as_float(w & 0xffff0000u); }

struct EpiProj {
    static constexpr bool PERM = true, AFTER_DRAIN = false;
    unsigned char* ws; unsigned char* outb; const float* hlb;
    __device__ __forceinline__ void operator()(const f32x4 (&acc)[2][2][4][2], const Unit& u, int wr, int wc, int fr, int fq) const {
        const int grp = u.pn >> 2;
        const int cbase = (u.pn & 3) * 256 + wc * 32 + 8 * fq;
        const int row0 = u.pm * BM + wr * 64 + fr;
        bf16_t* base; int rlim;
        if (grp < 6) { base = (bf16_t*)(ws + WS_GRP0 + (size_t)grp * GRP_BYTES); rlim = M_REAL; } else { base = (bf16_t*)(outb + (size_t)(grp - 6) * GATE_BYTES); rlim = M_MAIN; }
        const int mode = (grp == 0 || grp == 4) ? 0 : (grp == 1) ? 1 : (grp == 2 || grp == 5) ? 2 : (grp == 3) ? 3 : 4;
        float lbv[2][8];
#pragma unroll
        for (int bj = 0; bj < 2; ++bj)
#pragma unroll
            for (int e = 0; e < 8; ++e) lbv[bj][e] = 0.f;
        if (mode == 3) {
#pragma unroll
            for (int bj = 0; bj < 2; ++bj)
#pragma unroll
                for (int e = 0; e < 8; ++e) { const int c = cbase + bj * HALF + e; lbv[bj][e] = __builtin_amdgcn_rcpf(1.0f + __expf(hlb[1024 + c] - hlb[c])); }
        }
#pragma unroll
        for (int ai = 0; ai < 2; ++ai)
#pragma unroll
            for (int m = 0; m < 4; ++m) {
                const int r = row0 + ai * HALF + m * 16;
                if (r < rlim) {
                    bf16_t* rowp = base + (size_t)r * 1024 + cbase;
#pragma unroll
                    for (int bj = 0; bj < 2; ++bj) {
                        f32x4 v0 = acc[ai][bj][m][0], v1 = acc[ai][bj][m][1];
                        if (mode == 1) {
#pragma unroll
                            for (int e = 0; e < 4; ++e) { float x = v0[e]; v0[e] = x * fsig(x * (1.5957691216f + 0.0713548163f * x * x)); x = v1[e]; v1[e] = x * fsig(x * (1.5957691216f + 0.0713548163f * x * x)); }
                        } else if (mode == 2) {
#pragma unroll
                            for (int e = 0; e < 4; ++e) { v0[e] = v0[e] * fsig(v0[e]); v1[e] = v1[e] * fsig(v1[e]); }
                        } else if (mode == 3) {
#pragma unroll
                            for (int e = 0; e < 4; ++e) { const float l0 = lbv[bj][e], l1 = lbv[bj][4 + e]; v0[e] = __logf(l0 + (1.0f - l0) * fsig(v0[e])); v1[e] = __logf(l1 + (1.0f - l1) * fsig(v1[e])); }
                        } else if (mode == 4) {
#pragma unroll
                            for (int e = 0; e < 4; ++e) { v0[e] = fsig(v0[e]); v1[e] = fsig(v1[e]); }
                        }
                        *(u32x4*)(rowp + bj * HALF) = pack8(v0, v1);
                    }
                }
            }
    }
};

template <int WHICH> struct EpiGate {
    static constexpr bool PERM = true, AFTER_DRAIN = false;
    const bf16_t* gate; const bf16_t* prev; bf16_t* out;
    __device__ __forceinline__ void operator()(const f32x4 (&acc)[2][2][4][2], const Unit& u, int wr, int wc, int fr, int fq) const {
        const int cbase = u.pn * BM + wc * 32 + 8 * fq;
        const int row0 = u.pm * BM + wr * 64 + fr;
#pragma unroll
        for (int ai = 0; ai < 2; ++ai)
#pragma unroll
            for (int m = 0; m < 4; ++m) {
                const size_t off = (size_t)(row0 + ai * HALF + m * 16) * 1024 + cbase;
#pragma unroll
                for (int bj = 0; bj < 2; ++bj) {
                    const u32x4 g = *(const u32x4*)(gate + off + bj * HALF);
                    f32x4 v0 = acc[ai][bj][m][0], v1 = acc[ai][bj][m][1];
                    v0[0] *= bf_lo(g.x); v0[1] *= bf_hi(g.x); v0[2] *= bf_lo(g.y); v0[3] *= bf_hi(g.y);
                    v1[0] *= bf_lo(g.z); v1[1] *= bf_hi(g.z); v1[2] *= bf_lo(g.w); v1[3] *= bf_hi(g.w);
                    if (WHICH == 1) {
                        const u32x4 q = *(const u32x4*)(prev + off + bj * HALF);
                        v0[0] += bf_lo(q.x); v0[1] += bf_hi(q.x); v0[2] += bf_lo(q.y); v0[3] += bf_hi(q.y);
                        v1[0] += bf_lo(q.z); v1[1] += bf_hi(q.z); v1[2] += bf_lo(q.w); v1[3] += bf_hi(q.w);
                    }
                    *(u32x4*)(out + off + bj * HALF) = pack8(v0, v1);
                }
            }
    }
};

struct EpiF32 {
    static constexpr bool PERM = true, AFTER_DRAIN = false;
    float* out;
    __device__ __forceinline__ void operator()(const f32x4 (&acc)[2][2][4][2], const Unit& u, int wr, int wc, int fr, int fq) const {
        const int cbase = u.pn * BM + wc * 32 + 8 * fq;
        const int row0 = u.pm * BM + wr * 64 + fr;
#pragma unroll
        for (int ai = 0; ai < 2; ++ai)
#pragma unroll
            for (int m = 0; m < 4; ++m) {
                float* rowp = out + (size_t)(row0 + ai * HALF + m * 16) * 1024 + cbase;
#pragma unroll
                for (int bj = 0; bj < 2; ++bj) { *(f32x4*)(rowp + bj * HALF) = acc[ai][bj][m][0]; *(f32x4*)(rowp + bj * HALF + 4) = acc[ai][bj][m][1]; }
            }
    }
};

struct EpiRelu2 {
    static constexpr bool PERM = true, AFTER_DRAIN = false;
    bf16_t* out;
    __device__ __forceinline__ void operator()(const f32x4 (&acc)[2][2][4][2], const Unit& u, int wr, int wc, int fr, int fq) const {
        const int cbase = u.pn * BM + wc * 32 + 8 * fq;
        const int row0 = u.pm * BM + wr * 64 + fr;
#pragma unroll
        for (int ai = 0; ai < 2; ++ai)
#pragma unroll
            for (int m = 0; m < 4; ++m) {
                bf16_t* rowp = out + (size_t)(row0 + ai * HALF + m * 16) * 4096 + cbase;
#pragma unroll
                for (int bj = 0; bj < 2; ++bj) {
                    f32x4 v0 = acc[ai][bj][m][0], v1 = acc[ai][bj][m][1];
#pragma unroll
                    for (int e = 0; e < 4; ++e) { const float a = fmaxf(v0[e], 0.f), b = fmaxf(v1[e], 0.f); v0[e] = a * a; v1[e] = b * b; }
                    *(u32x4*)(rowp + bj * HALF) = pack8(v0, v1);
                }
            }
    }
};

template <class Epi, class Sched, bool ALIGN_EPI = false, bool SP2 = false>
__device__ __forceinline__ void gemm_phase(PG8_LAS unsigned char* lds, const Gemm g, const Sched& S, const Epi& E) {
    const int tid = threadIdx.x, wid = __builtin_amdgcn_readfirstlane(tid >> 6), lane = tid & 63, wr = wid >> 2, wc = wid & 3, fr = lane & 15, fq = lane >> 4;
    const int K = g.K, nt = K / BK;
    unsigned voffA[2], voffB[2];
#pragma unroll
    for (int i = 0; i < 2; ++i) { int R, C; stage_rc(tid * 16 + i * 8192, R, C); const int Rb = Epi::PERM ? ((R & ~31) + perm32(R & 31)) : R;
        voffA[i] = (unsigned)(R * K + C) * 2u; voffB[i] = (unsigned)(Rb * K + C) * 2u; }
    const size_t kstep = (size_t)(BK * 2);
    const size_t hstep = (size_t)HALF * K * 2;
    const size_t tstep = 2 * hstep;
    const unsigned ldsw = (unsigned)wid * 1024u;
    const int aoff = lds_byte(wr * 64 + fr, fq * 8), boff = lds_byte(wc * 32 + fr, fq * 8);
#define PG8_SA(b, h) (((b) * 2 + (h)) * HTB)
#define PG8_SB(b, h) ((4 + (b) * 2 + (h)) * HTB)
#define PG8_STAGE(bufoff, gbase, voff) do { _Pragma("unroll") for (int _i = 0; _i < 2; ++_i) \
        __builtin_amdgcn_global_load_lds((const unsigned*)((const char*)(gbase) + (voff)[_i]), (PG8_LAS unsigned*)(lds + (bufoff) + ldsw + _i * 8192), 16, 0, 0); } while (0)
#define PG8_LDA(dst, b, h) do { _Pragma("unroll") for (int m = 0; m < 4; ++m) _Pragma("unroll") for (int k = 0; k < 2; ++k) dst[m][k] = *(const PG8_LAS bf16x8*)(lds + PG8_SA(b, h) + aoff + m * 2048 + k * 1024); } while (0)
#define PG8_LDB(dst, b, h) do { _Pragma("unroll") for (int n = 0; n < 2; ++n) _Pragma("unroll") for (int k = 0; k < 2; ++k) dst[n][k] = *(const PG8_LAS bf16x8*)(lds + PG8_SB(b, h) + boff + n * 2048 + k * 1024); } while (0)
#define PG8_MMA(ai, bj, At, Bt) do { __builtin_amdgcn_s_setprio(1); _Pragma("unroll") for (int m = 0; m < 4; ++m) _Pragma("unroll") for (int n = 0; n < 2; ++n) _Pragma("unroll") for (int k = 0; k < 2; ++k) \
        acc[ai][bj][m][n] = __builtin_amdgcn_mfma_f32_16x16x32_bf16(Bt[n][k], At[m][k], acc[ai][bj][m][n], 0, 0, 0); __builtin_amdgcn_s_setprio(0); } while (0)
#define PG8_WAIT_V(n) asm volatile("s_waitcnt vmcnt(" #n ")" ::: "memory")
#define PG8_WAIT_L(n) asm volatile("s_waitcnt lgkmcnt(" #n ")" ::: "memory")
#define PG8_BAR __builtin_amdgcn_s_barrier()
#define PG8_SCHED __builtin_amdgcn_sched_barrier(0)
    Unit cur, nxt; int ui = 0;
    if (!S.next(0, cur)) return;
    f32x4 acc[2][2][4][2];
#pragma unroll
    for (int a = 0; a < 2; ++a)
#pragma unroll
        for (int b = 0; b < 2; ++b)
#pragma unroll
            for (int m = 0; m < 4; ++m)
#pragma unroll
                for (int n = 0; n < 2; ++n) acc[a][b][m][n] = (f32x4){0.f, 0.f, 0.f, 0.f};
    bf16x8 At[4][2], B0[2][2], B1[2][2];
    const char* cA = (const char*)g.A + (size_t)cur.pm * tstep; const char* cB = (const char*)g.Bt + (size_t)cur.pn * tstep;
    S.a_ready(cur);
    if constexpr (SP2) {
        PG8_STAGE(PG8_SB(0, 0), cB, voffB); PG8_STAGE(PG8_SB(0, 1), cB + hstep, voffB); PG8_STAGE(PG8_SA(0, 0), cA, voffA); PG8_STAGE(PG8_SA(0, 1), cA + hstep, voffA);
        if (wr == 1) PG8_BAR;
        PG8_WAIT_V(2); PG8_BAR;
        PG8_STAGE(PG8_SB(1, 0), cB + kstep, voffB); PG8_STAGE(PG8_SA(1, 0), cA + kstep, voffA); PG8_STAGE(PG8_SB(1, 1), cB + hstep + kstep, voffB);
        PG8_WAIT_V(6); PG8_BAR;
    } else {
        PG8_STAGE(PG8_SB(0, 0), cB, voffB); PG8_STAGE(PG8_SA(0, 0), cA, voffA); PG8_STAGE(PG8_SB(0, 1), cB + hstep, voffB); PG8_STAGE(PG8_SA(0, 1), cA + hstep, voffA);
        if (wr == 1) PG8_BAR;
        PG8_WAIT_V(4); PG8_BAR;
        PG8_STAGE(PG8_SB(1, 0), cB + kstep, voffB); PG8_STAGE(PG8_SA(1, 0), cA + kstep, voffA); PG8_STAGE(PG8_SB(1, 1), cB + hstep + kstep, voffB);
        PG8_WAIT_V(6); PG8_BAR;
    }
    for (;;) {
        const bool has_next = S.next(ui + 1, nxt);
        const char* nA = has_next ? (const char*)g.A + (size_t)nxt.pm * tstep : cA; const char* nB = has_next ? (const char*)g.Bt + (size_t)nxt.pn * tstep : cB;
        for (int t = 0; t < nt; t += 2) {
            const bool last = (t == nt - 2);
            const char* a1 = cA + (size_t)(t + 1) * kstep;
            const char* a2 = last ? nA : cA + (size_t)(t + 2) * kstep; const char* b2 = last ? nB : cB + (size_t)(t + 2) * kstep;
            const char* a3 = a2 + kstep; const char* b3 = b2 + kstep;
            if (last && has_next) S.a_ready(nxt);
            if constexpr (SP2) {
            PG8_LDB(B0, 0, 0); PG8_LDB(B1, 0, 1); PG8_SCHED; PG8_LDA(At, 0, 0); PG8_STAGE(PG8_SA(1, 1), a1 + hstep, voffA);
            PG8_WAIT_V(8); PG8_WAIT_L(0); PG8_BAR; PG8_MMA(0, 0, At, B0); PG8_MMA(0, 1, At, B1); PG8_BAR; PG8_SCHED;
            PG8_LDA(At, 0, 1); PG8_STAGE(PG8_SB(0, 0), b2, voffB); PG8_STAGE(PG8_SB(0, 1), b2 + hstep, voffB); PG8_STAGE(PG8_SA(0, 0), a2, voffA);
            PG8_WAIT_V(8); PG8_WAIT_L(0); PG8_BAR; PG8_MMA(1, 0, At, B0); PG8_MMA(1, 1, At, B1); PG8_BAR; PG8_SCHED;
            PG8_LDB(B0, 1, 0); PG8_LDB(B1, 1, 1); PG8_SCHED; PG8_LDA(At, 1, 0); PG8_STAGE(PG8_SA(0, 1), a2 + hstep, voffA);
            PG8_WAIT_V(8); PG8_WAIT_L(0); PG8_BAR; PG8_MMA(0, 0, At, B0); PG8_MMA(0, 1, At, B1); PG8_BAR; PG8_SCHED;
            PG8_LDA(At, 1, 1); PG8_STAGE(PG8_SB(1, 0), b3, voffB); PG8_STAGE(PG8_SB(1, 1), b3 + hstep, voffB); PG8_STAGE(PG8_SA(1, 0), a3, voffA);
            PG8_WAIT_V(8); PG8_WAIT_L(0); PG8_BAR; PG8_MMA(1, 0, At, B0); PG8_MMA(1, 1, At, B1); PG8_BAR; PG8_SCHED;
            } else {
            PG8_LDB(B0, 0, 0); PG8_SCHED; PG8_LDA(At, 0, 0); PG8_STAGE(PG8_SA(1, 1), a1 + hstep, voffA);
            PG8_WAIT_L(8); PG8_BAR; PG8_WAIT_L(0); PG8_MMA(0, 0, At, B0); PG8_BAR; PG8_SCHED;
            PG8_LDB(B1, 0, 1); PG8_STAGE(PG8_SB(0, 0), b2, voffB);
            PG8_BAR; PG8_WAIT_L(0); PG8_MMA(0, 1, At, B1); PG8_BAR;
            PG8_LDA(At, 0, 1); PG8_STAGE(PG8_SA(0, 0), a2, voffA);
            PG8_BAR; PG8_WAIT_L(0); PG8_MMA(1, 0, At, B0); PG8_BAR; PG8_SCHED;
            PG8_STAGE(PG8_SB(0, 1), b2 + hstep, voffB);
            PG8_WAIT_V(6); PG8_BAR; PG8_MMA(1, 1, At, B1); PG8_BAR;
            PG8_LDB(B0, 1, 0); PG8_SCHED; PG8_LDA(At, 1, 0); PG8_STAGE(PG8_SA(0, 1), a2 + hstep, voffA);
            PG8_WAIT_L(8); PG8_BAR; PG8_WAIT_L(0); PG8_MMA(0, 0, At, B0); PG8_BAR; PG8_SCHED;
            PG8_LDB(B1, 1, 1); PG8_STAGE(PG8_SB(1, 0), b3, voffB);
            PG8_BAR; PG8_WAIT_L(0); PG8_MMA(0, 1, At, B1); PG8_BAR;
            PG8_LDA(At, 1, 1); PG8_STAGE(PG8_SA(1, 0), a3, voffA);
            PG8_BAR; PG8_WAIT_L(0); PG8_MMA(1, 0, At, B0); PG8_BAR; PG8_SCHED;
            PG8_STAGE(PG8_SB(1, 1), b3 + hstep, voffB);
            PG8_WAIT_V(6); PG8_BAR; PG8_MMA(1, 1, At, B1); PG8_BAR;
            }
        }
        if constexpr (ALIGN_EPI) { if (wr == 0) PG8_BAR; }
        if constexpr (!Epi::AFTER_DRAIN) { E(acc, cur, wr, wc, fr, fq); S.done(cur); }
        if (!has_next) break;
#pragma unroll
        for (int a = 0; a < 2; ++a)
#pragma unroll
            for (int b = 0; b < 2; ++b)
#pragma unroll
                for (int m = 0; m < 4; ++m)
#pragma unroll
                    for (int n = 0; n < 2; ++n) acc[a][b][m][n] = (f32x4){0.f, 0.f, 0.f, 0.f};
        cur = nxt; cA = nA; cB = nB; ++ui;
        if constexpr (ALIGN_EPI) { if (wr == 1) PG8_BAR; }
    }
    PG8_WAIT_V(0);
    if constexpr (!ALIGN_EPI) { if (wr == 0) PG8_BAR; }
    PG8_BAR;
    if constexpr (Epi::AFTER_DRAIN) { E.fused(acc, cur, wr, wc, fr, fq, lds, wid, lane); S.done(cur); }
#undef PG8_SA
#undef PG8_SB
#undef PG8_STAGE
#undef PG8_LDA
#undef PG8_LDB
#undef PG8_MMA
#undef PG8_WAIT_V
#undef PG8_WAIT_L
#undef PG8_BAR
#undef PG8_SCHED
}
}

#define LAS __attribute__((address_space(3)))
typedef unsigned short bf16_t;
typedef short bf16x8 __attribute__((ext_vector_type(8)));
typedef float f32x4 __attribute__((ext_vector_type(4)));
typedef unsigned u32x4 __attribute__((ext_vector_type(4)));
typedef unsigned u32x2 __attribute__((ext_vector_type(2)));
constexpr int NWAVES = 8, NTHREADS = 512;
constexpr int LDS_BYTES = 147456;
constexpr int NPHASES = 11;

struct Params {
    const float *x_prompt, *x_sample, *state_conv, *state_rglru, *state_hgrn, *meta, *gains, *w_in, *conv_w, *conv_b, *rg_w, *rg_b, *ig_w, *ig_b, *lam, *hgrn_lb, *gnorm, *w_a, *w_b, *w_out, *w_up, *w_down;
    float* out; unsigned char* ws;
    int ph_lo, ph_hi, use_bar, pad;
};

using pg8::cvt_pk_bf16;
__device__ __forceinline__ float bflo(unsigned w) { return __uint_as_float(w << 16); }
__device__ __forceinline__ float bfhi(unsigned w) { return __uint_as_float(w & 0xffff0000u); }
__device__ __forceinline__ float bf2f(bf16_t h) { return __uint_as_float((unsigned)h << 16); }
__device__ __forceinline__ bf16_t f2bf(float f) { return (bf16_t)(cvt_pk_bf16(f, 0.f) & 0xffffu); }
__device__ __forceinline__ float fsig(float x) { return __builtin_amdgcn_rcpf(1.0f + __expf(-x)); }
__device__ __forceinline__ float wave_sum(float v) {
#pragma unroll
    for (int o = 1; o < 64; o <<= 1) v += __shfl_xor(v, o);
    return v;
}
__device__ __forceinline__ void lds_barrier() { asm volatile("s_waitcnt lgkmcnt(0)" ::: "memory"); __builtin_amdgcn_s_barrier(); asm volatile("" ::: "memory"); }
__device__ __forceinline__ f32x4 mfma16(bf16x8 first, bf16x8 second, f32x4 c) { return __builtin_amdgcn_mfma_f32_16x16x32_bf16(first, second, c, 0, 0, 0); }

#define XB_TMO      128
#define XB_XCNT(j)  (256  + 64 * (j))
#define XB_XSUB(j)  (1280 + 64 * (j))
#define XB_XGEN(j)  (2304 + 64 * (j))
#define XB_TOP      3328
#define XB_TOPGEN   3392
#define XCD_BAR_WORDS 3456
#define XB_SPIN_CAP (1u << 18)

__device__ __forceinline__ unsigned xb_ld(unsigned* p)              { return __hip_atomic_load(p, __ATOMIC_RELAXED, __HIP_MEMORY_SCOPE_AGENT); }
__device__ __forceinline__ unsigned xb_add(unsigned* p, unsigned v) { return __hip_atomic_fetch_add(p, v, __ATOMIC_RELAXED, __HIP_MEMORY_SCOPE_AGENT); }
__device__ __forceinline__ unsigned xb_xcc_id() { return (unsigned)__builtin_amdgcn_s_getreg((3 << 11) | 20) & 0xFu; }
#define XB_SPIN(cond, bar) do { unsigned _sp = 0; while (cond) { __builtin_amdgcn_s_sleep(1); \
    if ((++_sp & 255u) == 0u) { if (xb_ld(&(bar)[XB_TMO])) break; if (_sp > XB_SPIN_CAP) { atomicAdd(&(bar)[XB_TMO], 1u); break; } } } } while (0)

struct XcdBarrier {
    unsigned* bar; unsigned x;
    volatile LAS unsigned* st;
};

__device__ __forceinline__ XcdBarrier xcd_barrier_post(unsigned* bar, volatile LAS unsigned* st) {
    XcdBarrier b; b.bar = bar; b.x = xb_xcc_id(); b.st = st;
    if (threadIdx.x == 0) (void)xb_add(&bar[XB_XCNT(b.x)], 1u);
    return b;
}
__device__ __forceinline__ void xcd_barrier_complete(unsigned* bar, unsigned x, unsigned& nloc, unsigned& nx) {
    const unsigned G = gridDim.x * gridDim.y * gridDim.z;
    unsigned sum, cnt, mine, sp = 0u;
    for (;;) {
        sum = 0u; cnt = 0u; mine = 0u;
#pragma unroll
        for (unsigned j = 0; j < 16; ++j) { const unsigned c = xb_ld(&bar[XB_XCNT(j)]); sum += c; cnt += (c > 0u) ? 1u : 0u; mine = (j == x) ? c : mine; }
        if (sum == G) break;
        __builtin_amdgcn_s_sleep(1);
        if ((++sp & 255u) == 0u) { if (xb_ld(&bar[XB_TMO])) break; if (sp > XB_SPIN_CAP) { atomicAdd(&bar[XB_TMO], 1u); break; } }
    }
    nloc = mine > 0u ? mine : 1u; nx = cnt > 0u ? cnt : 1u;
}

__device__ __forceinline__ void xcd_barrier(const XcdBarrier& b) {
    asm volatile("s_waitcnt vmcnt(0)" ::: "memory");
    __syncthreads();
    if (threadIdx.x == 0) {
        unsigned* bar = b.bar;
        __builtin_amdgcn_s_waitcnt(0);
        unsigned nloc = b.st[0], nx = b.st[1];
        if (nloc == 0u) { xcd_barrier_complete(bar, b.x, nloc, nx); b.st[0] = nloc; b.st[1] = nx; }
        const unsigned old = xb_add(&bar[XB_XSUB(b.x)], 1u);
        const unsigned gen = old / nloc;
        if (old + 1u == (gen + 1u) * nloc) {
            __builtin_amdgcn_fence(__ATOMIC_RELEASE, "agent");
            asm volatile("s_waitcnt vmcnt(0)" ::: "memory");
            const unsigned og = xb_add(&bar[XB_TOP], 1u);
            const unsigned tg = og / nx;
            if (og + 1u == (tg + 1u) * nx) xb_add(&bar[XB_TOPGEN], 1u);
            else XB_SPIN(xb_ld(&bar[XB_TOPGEN]) == tg, bar);
            __builtin_amdgcn_fence(__ATOMIC_ACQUIRE, "agent");
            xb_add(&bar[XB_XGEN(b.x)], 1u);
            asm volatile("s_waitcnt vmcnt(0)" ::: "memory");
        } else {
            XB_SPIN(xb_ld(&bar[XB_XGEN(b.x)]) == gen, bar);
            __builtin_amdgcn_fence(__ATOMIC_ACQUIRE, "agent");
            asm volatile("s_waitcnt vmcnt(0)" ::: "memory");
        }
    }
    __syncthreads();
}


__device__ __forceinline__ void p0_transpose_item(const float* W, int K, int N, bf16_t* WT, int row_off, LAS float* scr, int item, int lane) {
    const int nblk = N / 32, kb = item / nblk, nb = item % nblk, k0 = 64 * kb, n0 = 32 * nb;
#pragma unroll 8
    for (int i = 0; i < 32; ++i) { const int kk = 2 * i + (lane >> 5); scr[kk * 33 + (lane & 31)] = W[(size_t)(k0 + kk) * N + n0 + (lane & 31)]; }
    asm volatile("s_waitcnt lgkmcnt(0)" ::: "memory");
    const int c = lane & 7;
#pragma unroll
    for (int j = 0; j < 4; ++j) { const int n = (lane >> 3) + 8 * j; const LAS float* s = scr + (8 * c) * 33 + n;
        u32x4 o; o.x = cvt_pk_bf16(s[0 * 33], s[1 * 33]); o.y = cvt_pk_bf16(s[2 * 33], s[3 * 33]); o.z = cvt_pk_bf16(s[4 * 33], s[5 * 33]); o.w = cvt_pk_bf16(s[6 * 33], s[7 * 33]);
        *(u32x4*)(WT + (size_t)(row_off + n0 + n) * K + k0 + 8 * c) = o; }
    asm volatile("s_waitcnt lgkmcnt(0)" ::: "memory");
}
__device__ __forceinline__ void rms_row_to_bf16(const float* xrow, const float* g, bf16_t* orow, int lane) {
    const f32x4* xr = (const f32x4*)xrow + lane; const f32x4* gr = (const f32x4*)g + lane;
    f32x4 v[4]; float s = 0.f;
#pragma unroll
    for (int j = 0; j < 4; ++j) { v[j] = xr[64 * j]; s += (v[j].x * v[j].x + v[j].y * v[j].y) + (v[j].z * v[j].z + v[j].w * v[j].w); }
    const float rstd = 1.0f / sqrtf(wave_sum(s) * (1.f / D) + EPS);
    u32x2* o8 = (u32x2*)orow + lane;
#pragma unroll
    for (int j = 0; j < 4; ++j) { const f32x4 gg = gr[64 * j]; u32x2 w; w.x = cvt_pk_bf16(v[j].x * rstd * gg.x, v[j].y * rstd * gg.y); w.y = cvt_pk_bf16(v[j].z * rstd * gg.z, v[j].w * rstd * gg.w); o8[64 * j] = w; }
}
__device__ __forceinline__ void p0_prologue(const Params& p, LAS unsigned char* lds) {
    const int tid = threadIdx.x, lane = tid & 63, wave = __builtin_amdgcn_readfirstlane(tid >> 6);
    LAS float* scr = (LAS float*)(lds + wave * 16384);
    const int gw = blockIdx.x * NWAVES + wave, NGW = gridDim.x * NWAVES;
    constexpr int I_IN = (D / 64) * (DIN / 32), I_UP = (D / 64) * (DFF / 32), I_DN = (DFF / 64) * (D / 32), I_SQ = (D / 64) * (D / 32), I_RG = 8;
    constexpr int NITEMS = I_IN + I_UP + I_DN + 3 * I_SQ + 16 * I_RG;
    unsigned char* ws = p.ws;
    for (int it = gw; it < NITEMS; it += NGW) {
        int r = it;
        if (r < I_IN) { p0_transpose_item(p.w_in, D, DIN, (bf16_t*)(ws + WS_WIN), 0, scr, r, lane); continue; } r -= I_IN;
        if (r < I_UP) { p0_transpose_item(p.w_up, D, DFF, (bf16_t*)(ws + WS_WUP), 0, scr, r, lane); continue; } r -= I_UP;
        if (r < I_DN) { p0_transpose_item(p.w_down, DFF, D, (bf16_t*)(ws + WS_WDN), 0, scr, r, lane); continue; } r -= I_DN;
        if (r < I_SQ) { p0_transpose_item(p.w_a, D, D, (bf16_t*)(ws + WS_WA), 0, scr, r, lane); continue; } r -= I_SQ;
        if (r < I_SQ) { p0_transpose_item(p.w_b, D, D, (bf16_t*)(ws + WS_WB), 0, scr, r, lane); continue; } r -= I_SQ;
        if (r < I_SQ) { p0_transpose_item(p.w_out, D, D, (bf16_t*)(ws + WS_WOUT), 0, scr, r, lane); continue; } r -= I_SQ;
        { const int hm = r / I_RG, ii = r % I_RG, h = hm >> 1, which = hm & 1;
          p0_transpose_item((which ? p.ig_w : p.rg_w) + (size_t)h * 128 * 128, 128, 128, (bf16_t*)(ws + WS_WRG), h * 256 + which * 128, scr, ii, lane); }
    }
    bf16_t* XN = (bf16_t*)((unsigned char*)p.out + OFF_SS * 4);
    for (int m = gw; m < M_PAD; m += NGW) {
        bf16_t* orow = XN + (size_t)m * D;
        if (m < M_REAL) {
            const float* xrow = m < ROW_SAMPLE ? p.x_prompt + (size_t)m * D : m < M_MAIN ? p.x_sample + (size_t)(m - ROW_SAMPLE) * D : p.meta + (size_t)(m - ROW_META) * D;
            rms_row_to_bf16(xrow, p.gains, orow, lane);
        } else {
            u32x2* o8 = (u32x2*)orow + lane;
#pragma unroll
            for (int j = 0; j < 4; ++j) o8[64 * j] = (u32x2){0u, 0u};
        }
    }
}

__device__ __forceinline__ float softplus_neg(float lam) {
    const float x = __expf(-lam);
    return x < 0.03f ? x * (1.0f - x * (0.5f - x * (1.0f / 3.0f - 0.25f * x))) : __logf(1.0f + x);
}
__device__ __forceinline__ float neg_expm1(float y) {
    if (y > -0.3f) { float q = 1.0f / 5040.0f; q = q * y + 1.0f / 720.0f; q = q * y + 1.0f / 120.0f; q = q * y + 1.0f / 24.0f; q = q * y + 1.0f / 6.0f; q = q * y + 0.5f; q = q * y + 1.0f; return -y * q; }
    return 1.0f - __expf(y);
}
constexpr int RG_WB = 0, RG_UCB = 69632, RG_UCF = 87040;
template <int CTRL> __device__ __forceinline__ float dppf(float oldv, float src) { return __builtin_bit_cast(float, __builtin_amdgcn_update_dpp(__builtin_bit_cast(int, oldv), __builtin_bit_cast(int, src), CTRL, 0xF, 0xF, false)); }
template <int CTRL> __device__ __forceinline__ void scan_step(float& a, float& b2) { const float ap = dppf<CTRL>(1.0f, a), bp = dppf<CTRL>(0.0f, b2); b2 = a * bp + b2; a = a * ap; }
template <int CTRL, int DD> __device__ __forceinline__ void scan_step8(float& a, float& b2, int fr) { float ap = dppf<CTRL>(1.0f, a), bp = dppf<CTRL>(0.0f, b2); if ((fr & 7) < DD) { ap = 1.0f; bp = 0.0f; } b2 = a * bp + b2; a = a * ap; }

constexpr int RG_CW = 120832;
__device__ __forceinline__ void rg_issue_loads(const Params& p, int h, int b, int j, u32x4 (&ur)[8]) {
    const int tid = threadIdx.x, crow = tid >> 3, cgp = tid & 7, ch0 = h * 128 + 16 * cgp;
    const bf16_t* U = (const bf16_t*)(p.ws + WS_GRP0 + G_U * GRP_BYTES);
    const bool rowvalid = j > 0 || crow < 16;
#pragma unroll
    for (int k = 0; k < 4; ++k) {
        const int pp = (j == 0 ? crow : 16 + 64 * (j - 1) + crow) + k - 3;
        if (rowvalid && pp >= 0) { const size_t grow = pp < 16 ? (size_t)(ROW_META + pp) : (size_t)b * 2048 + pp - 16; const u32x4* src = (const u32x4*)(U + grow * 1024 + ch0); ur[2 * k] = src[0]; ur[2 * k + 1] = src[1]; }
        else { ur[2 * k] = (u32x4){0u, 0u, 0u, 0u}; ur[2 * k + 1] = (u32x4){0u, 0u, 0u, 0u}; }
    }
}
template <int KIND>
__device__ __forceinline__ void rg_unit(const Params& p, LAS unsigned char* lds, const bf16x8 (&bw)[2][4], const f32x4 rgb, const f32x4 igb, const f32x4 sp8, int h, int b, int j, int st, f32x4& hcar, bool use_car, bool dry,
                                        u32x4 (&ur)[8], bool has_next, int nb, int nj) {
    const int tid = threadIdx.x, lane = tid & 63, w = __builtin_amdgcn_readfirstlane(tid >> 6), fr = lane & 15, fq = lane >> 4;
    constexpr bool sample = KIND == 2;
    unsigned char* ws = p.ws;
    const bf16_t* U = (const bf16_t*)(ws + WS_GRP0 + G_U * GRP_BYTES);
    bf16_t* GA = (bf16_t*)(ws + WS_GRP0 + G_GA * GRP_BYTES);
    float* AGGA = (float*)(ws + WS_AGGA); float* AGGB = (float*)(ws + WS_AGGB);
    LAS unsigned char* UCB = lds + RG_UCB; LAS float* UCF = (LAS float*)(lds + RG_UCF); const LAS float* CW = (const LAS float*)(lds + RG_CW);
    const int c0 = h * 128 + 16 * w + 4 * fq;
    const int crow = tid >> 3, cgp = tid & 7, ch0 = h * 128 + 16 * cgp;
    u32x2 gq[4];
    if (KIND != 0) {
#pragma unroll
        for (int m = 0; m < 4; ++m) { const int row = 16 * m + fr; const size_t grow = sample ? (size_t)ROW_SAMPLE + 64 * st + row : (size_t)b * 2048 + 64 * (j - 1) + row; gq[m] = *(const u32x2*)(GA + grow * 1024 + c0); }
    }
    {
        float uc[16];
#pragma unroll
        for (int q = 0; q < 4; ++q) { const f32x4 v = *(const LAS f32x4*)(CW + 4 * 128 + 16 * cgp + 4 * q); uc[4 * q] = v.x; uc[4 * q + 1] = v.y; uc[4 * q + 2] = v.z; uc[4 * q + 3] = v.w; }
        const bool rowvalid = sample || j > 0 || crow < 16;
#pragma unroll
        for (int k = 0; k < 4; ++k) {
            float val[16];
            u32x4 a, b2; bool isf = false; const float* srcf = nullptr;
            if (sample) { const int seg = crow >> 3, t = crow & 7, db = 8 * st + seg, ts = t + k - 3;
                if (ts >= 0) { const u32x4* src = (const u32x4*)(U + (size_t)(ROW_SAMPLE + db * 8 + ts) * 1024 + ch0); a = src[0]; b2 = src[1]; }
                else { isf = true; srcf = p.state_conv + ((size_t)db * 3 + ts + 3) * 1024 + ch0; a = (u32x4){0u, 0u, 0u, 0u}; b2 = a; } }
            else { a = ur[2 * k]; b2 = ur[2 * k + 1]; }
            val[0] = bflo(a.x); val[1] = bfhi(a.x); val[2] = bflo(a.y); val[3] = bfhi(a.y); val[4] = bflo(a.z); val[5] = bfhi(a.z); val[6] = bflo(a.w); val[7] = bfhi(a.w);
            val[8] = bflo(b2.x); val[9] = bfhi(b2.x); val[10] = bflo(b2.y); val[11] = bfhi(b2.y); val[12] = bflo(b2.z); val[13] = bfhi(b2.z); val[14] = bflo(b2.w); val[15] = bfhi(b2.w);
            if (sample && isf) {
#pragma unroll
                for (int q = 0; q < 4; ++q) { const f32x4 v = ((const f32x4*)srcf)[q]; val[4 * q] = v.x; val[4 * q + 1] = v.y; val[4 * q + 2] = v.z; val[4 * q + 3] = v.w; } }
#pragma unroll
            for (int q = 0; q < 4; ++q) { const f32x4 wv = *(const LAS f32x4*)(CW + k * 128 + 16 * cgp + 4 * q); uc[4 * q] += wv.x * val[4 * q]; uc[4 * q + 1] += wv.y * val[4 * q + 1]; uc[4 * q + 2] += wv.z * val[4 * q + 2]; uc[4 * q + 3] += wv.w * val[4 * q + 3]; }
        }
        if (!rowvalid) {
#pragma unroll
            for (int e = 0; e < 16; ++e) uc[e] = 0.f; }
#pragma unroll
        for (int q = 0; q < 4; ++q) *(LAS f32x4*)(UCF + crow * 132 + 16 * cgp + 4 * q) = (f32x4){uc[4 * q], uc[4 * q + 1], uc[4 * q + 2], uc[4 * q + 3]};
        u32x4 o0, o1;
        o0.x = cvt_pk_bf16(uc[0], uc[1]); o0.y = cvt_pk_bf16(uc[2], uc[3]); o0.z = cvt_pk_bf16(uc[4], uc[5]); o0.w = cvt_pk_bf16(uc[6], uc[7]);
        o1.x = cvt_pk_bf16(uc[8], uc[9]); o1.y = cvt_pk_bf16(uc[10], uc[11]); o1.z = cvt_pk_bf16(uc[12], uc[13]); o1.w = cvt_pk_bf16(uc[14], uc[15]);
        *(LAS u32x4*)(UCB + crow * 272 + 32 * cgp) = o0; *(LAS u32x4*)(UCB + crow * 272 + 32 * cgp + 16) = o1;
    }
    if (!sample && has_next) rg_issue_loads(p, h, nb, nj, ur);
    f32x4 hin = (f32x4){0.f, 0.f, 0.f, 0.f};
    if (KIND == 1) {
        if (use_car) hin = hcar;
        else {
            int jj = 0;
            for (; jj + 4 <= j; jj += 4) {
                f32x4 A4[4], B4[4];
#pragma unroll
                for (int q = 0; q < 4; ++q) { const size_t o = ((size_t)b * 33 + jj + q) * 1024 + c0; A4[q] = *(const f32x4*)(AGGA + o); B4[q] = *(const f32x4*)(AGGB + o); }
#pragma unroll
                for (int q = 0; q < 4; ++q) hin = A4[q] * hin + B4[q];
            }
            for (; jj < j; ++jj) { const size_t o = ((size_t)b * 33 + jj) * 1024 + c0; const f32x4 A4 = *(const f32x4*)(AGGA + o), B4 = *(const f32x4*)(AGGB + o); hin = A4 * hin + B4; }
        }
    }
    lds_barrier();
    f32x4 accr[4], acci[4];
#pragma unroll
    for (int m = 0; m < 4; ++m) { accr[m] = (f32x4){0.f, 0.f, 0.f, 0.f}; acci[m] = (f32x4){0.f, 0.f, 0.f, 0.f}; }
#pragma unroll
    for (int m = 0; m < 4; ++m)
#pragma unroll
        for (int ks = 0; ks < 4; ++ks) { const bf16x8 af = *(const LAS bf16x8*)(UCB + (16 * m + fr) * 272 + 64 * ks + 16 * fq);
            accr[m] = mfma16(bw[0][ks], af, accr[m]); acci[m] = mfma16(bw[1][ks], af, acci[m]); }
    float a[4][4], bb[4][4];
#pragma unroll
    for (int m = 0; m < 4; ++m) {
        const int row = 16 * m + fr;
        const f32x4 ucv = *(const LAS f32x4*)(UCF + row * 132 + 16 * w + 4 * fq);
        const bool valid = sample || j > 0 || row < 16;
        const bool first = !sample && j == 0 && row == 0;
#pragma unroll
        for (int i = 0; i < 4; ++i) {
            const float r = fsig(accr[m][i] + rgb[i]), ig = fsig(acci[m][i] + igb[i]);
            const float la = -r * sp8[i];
            const float av = __expf(la);
            const float om = la > -2.0e-3f ? -2.0f * la * (1.0f + la) : (1.0f - av) * (1.0f + av);
            float mult = __builtin_amdgcn_sqrtf(om);
            if (first) mult = 1.0f;
            a[m][i] = valid ? av : 1.0f; bb[m][i] = valid ? mult * ig * ucv[i] : 0.0f;
        }
    }
    if (!sample) {
#pragma unroll
        for (int m = 0; m < 4; ++m)
#pragma unroll
            for (int i = 0; i < 4; ++i) { scan_step<0x111>(a[m][i], bb[m][i]); scan_step<0x112>(a[m][i], bb[m][i]); scan_step<0x114>(a[m][i], bb[m][i]); scan_step<0x118>(a[m][i], bb[m][i]); }
        float ca[4] = {1.f, 1.f, 1.f, 1.f}, cb[4] = {0.f, 0.f, 0.f, 0.f};
#pragma unroll
        for (int m = 0; m < 4; ++m)
#pragma unroll
            for (int i = 0; i < 4; ++i) { bb[m][i] = a[m][i] * cb[i] + bb[m][i]; a[m][i] = a[m][i] * ca[i]; ca[i] = dppf<0x15F>(0.f, a[m][i]); cb[i] = dppf<0x15F>(0.f, bb[m][i]); }
    } else {
#pragma unroll
        for (int m = 0; m < 4; ++m)
#pragma unroll
            for (int i = 0; i < 4; ++i) { scan_step8<0x111, 1>(a[m][i], bb[m][i], fr); scan_step8<0x112, 2>(a[m][i], bb[m][i], fr); scan_step8<0x114, 4>(a[m][i], bb[m][i], fr); }
    }
    if (KIND == 0) {
        if (fr == 15) { const size_t o = ((size_t)b * 33 + j) * 1024 + c0;
            *(f32x4*)(AGGA + o) = (f32x4){a[3][0], a[3][1], a[3][2], a[3][3]}; *(f32x4*)(AGGB + o) = (f32x4){bb[3][0], bb[3][1], bb[3][2], bb[3][3]}; }
    } else {
        f32x4 hv = hin;
#pragma unroll
        for (int m = 0; m < 4; ++m) {
            const int row = 16 * m + fr;
            size_t grow;
            if (sample) { const int db = 8 * st + (row >> 3); hin = *(const f32x4*)(p.state_rglru + (size_t)db * 1024 + c0); grow = (size_t)ROW_SAMPLE + 64 * st + row; }
            else grow = (size_t)b * 2048 + 64 * (j - 1) + row;
#pragma unroll
            for (int i = 0; i < 4; ++i) hv[i] = a[m][i] * hin[i] + bb[m][i];
            const u32x2 g = gq[m];
            u32x2 y; y.x = cvt_pk_bf16(hv[0] * bflo(g.x), hv[1] * bfhi(g.x)); y.y = cvt_pk_bf16(hv[2] * bflo(g.y), hv[3] * bfhi(g.y));
            if (!dry) *(u32x2*)(GA + grow * 1024 + c0) = y;
            if (dry) {} else if (sample) { if ((fr & 7) == 7) { const int db = 8 * st + (row >> 3); *(f32x4*)(p.out + OFF_HS + (size_t)db * 1024 + c0) = hv; } }
            else if (j == 32 && m == 3 && fr == 15) *(f32x4*)(p.out + OFF_HP + (size_t)b * 1024 + c0) = hv;
        }
        if (KIND == 1) {
#pragma unroll
            for (int i = 0; i < 4; ++i) hcar[i] = dppf<0x15F>(0.f, hv[i]);
        }
    }
    lds_barrier();
}

__device__ __forceinline__ void sub_barrier(unsigned* cnt, unsigned n) {
    asm volatile("s_waitcnt vmcnt(0)" ::: "memory");
    __syncthreads();
    if (threadIdx.x == 0) {
        __builtin_amdgcn_fence(__ATOMIC_RELEASE, "agent");
        asm volatile("s_waitcnt vmcnt(0)" ::: "memory");
        __hip_atomic_fetch_add(cnt, 1u, __ATOMIC_RELAXED, __HIP_MEMORY_SCOPE_AGENT);
        unsigned sp = 0;
        while (__hip_atomic_load(cnt, __ATOMIC_RELAXED, __HIP_MEMORY_SCOPE_AGENT) < n) { __builtin_amdgcn_s_sleep(2); if (++sp > (1u << 22)) break; }
        __builtin_amdgcn_fence(__ATOMIC_ACQUIRE, "agent");
        asm volatile("s_waitcnt vmcnt(0)" ::: "memory");
    }
    __syncthreads();
}

__device__ __forceinline__ void hgrn_sample_item(const Params& p, LAS unsigned char* lds, int db, int h, bool dry);
__device__ __forceinline__ void rg_work(const Params& p, LAS unsigned char* lds, int wg, int nwg, bool dry) {
    const int tid = threadIdx.x, lane = tid & 63, w = __builtin_amdgcn_readfirstlane(tid >> 6), fr = lane & 15, fq = lane >> 4;
    const int h = wg & 7, idx = wg >> 3, nidx = nwg >> 3;
    unsigned char* ws = p.ws;
    LAS unsigned char* WB = lds + RG_WB;
    __syncthreads();
    {   const bf16_t* wsrc = (const bf16_t*)(ws + WS_WRG) + (size_t)h * 256 * 128;
#pragma unroll
        for (int it = 0; it < 8; ++it) { const int row = (tid >> 4) + 32 * it, ch = tid & 15; *(LAS u32x4*)(WB + row * 272 + ch * 16) = *(const u32x4*)(wsrc + row * 128 + ch * 8); }
    }
    __syncthreads();
    bf16x8 bw[2][4];
#pragma unroll
    for (int nt = 0; nt < 2; ++nt)
#pragma unroll
        for (int ks = 0; ks < 4; ++ks) bw[nt][ks] = *(const LAS bf16x8*)(WB + (nt * 128 + 16 * w + fr) * 272 + 64 * ks + 16 * fq);
    const int c0 = h * 128 + 16 * w + 4 * fq;
    const f32x4 rgb = *(const f32x4*)(p.rg_b + c0), igb = *(const f32x4*)(p.ig_b + c0), lam4 = *(const f32x4*)(p.lam + c0);
    f32x4 sp8;
#pragma unroll
    for (int i = 0; i < 4; ++i) sp8[i] = 8.0f * softplus_neg(lam4[i]);
    f32x4 hcar = (f32x4){0.f, 0.f, 0.f, 0.f};
    for (int e = tid; e < 5 * 128; e += NTHREADS) { const int k = e >> 7, c = e & 127; ((LAS float*)(lds + RG_CW))[e] = k < 4 ? p.conv_w[(size_t)k * 1024 + h * 128 + c] : p.conv_b[h * 128 + c]; }
    __syncthreads();
    u32x4 ur[8];
    {   const int u0 = (NB * 33 * idx) / nidx, u1 = (NB * 33 * (idx + 1)) / nidx;
        if (u0 < u1) rg_issue_loads(p, h, u0 / 33, u0 % 33, ur);
        for (int ui = u0; ui < u1; ++ui) rg_unit<0>(p, lds, bw, rgb, igb, sp8, h, ui / 33, ui % 33, 0, hcar, false, dry, ur, ui + 1 < u1, (ui + 1) / 33, (ui + 1) % 33); }
    for (int st = idx; st < 16; st += nidx) rg_unit<2>(p, lds, bw, rgb, igb, sp8, h, 0, 1, st, hcar, false, dry, ur, false, 0, 0);
    for (int it = wg; it < DBATCH * 8; it += nwg) hgrn_sample_item(p, lds, it >> 3, it & 7, dry);
    sub_barrier((unsigned*)(ws + WS_CTL) + 8192 + (dry ? 64 : 0), (unsigned)nwg);
    {   const int u0 = (NB * 32 * idx) / nidx, u1 = (NB * 32 * (idx + 1)) / nidx;
        int pb = -1, pj = -1;
        if (u0 < u1) rg_issue_loads(p, h, u0 >> 5, (u0 & 31) + 1, ur);
        for (int ui = u0; ui < u1; ++ui) {
            const int b = ui >> 5, j = (ui & 31) + 1;
            rg_unit<1>(p, lds, bw, rgb, igb, sp8, h, b, j, 0, hcar, pb == b && pj == j - 1, dry, ur, ui + 1 < u1, (ui + 1) >> 5, ((ui + 1) & 31) + 1);
            pb = b; pj = j;
        } }
}

__device__ __forceinline__ void hgrn_sample_item(const Params& p, LAS unsigned char* lds, int db, int h, bool dry) {
    const int tid = threadIdx.x;
    unsigned char* ws = p.ws;
    const bf16_t* Qb = (const bf16_t*)(ws + WS_GRP0 + G_Q * GRP_BYTES); const bf16_t* LFb = (const bf16_t*)(ws + WS_GRP0 + G_LF * GRP_BYTES);
    bf16_t* Vb = (bf16_t*)(ws + WS_GRP0 + G_V * GRP_BYTES);
    LAS float* FF = (LAS float*)lds; LAS float* KK = FF + 1024; LAS float* QQ = KK + 1024; LAS float* VV = QQ + 1024; LAS float* ORED = VV + 1024;
    const size_t row0 = (size_t)ROW_SAMPLE + db * 8;
    {   const int k = tid & 127, tq = tid >> 7;
#pragma unroll
        for (int tt = 0; tt < 2; ++tt) { const int t = 2 * tq + tt; const size_t off = (row0 + t) * 1024 + h * 128 + k;
            const float fg = __expf(bf2f(LFb[off])); FF[k * 8 + t] = fg; KK[k * 8 + t] = 1.0f - fg; QQ[k * 8 + t] = bf2f(Qb[off]); VV[t * 128 + k] = bf2f(Vb[off]); }
    }
    const int kq = tid >> 5, v4 = tid & 31;
    lds_barrier();
    f32x4 O[8];
#pragma unroll
    for (int t = 0; t < 8; ++t) O[t] = (f32x4){0.f, 0.f, 0.f, 0.f};
    const size_t sbase = ((size_t)(db * 8 + h) * 128 + 8 * kq) * 128 + 4 * v4;
    const float* S0 = p.state_hgrn + sbase;
    float* S1 = p.out + OFF_SS + sbase;
    f32x4 S4[8];
#pragma unroll
    for (int kk = 0; kk < 8; ++kk) S4[kk] = *(const f32x4*)(S0 + kk * 128);
#pragma unroll 1
    for (int kk = 0; kk < 8; ++kk) {
        const int k = 8 * kq + kk;
        const f32x4 f0 = *(const LAS f32x4*)(FF + k * 8), f1 = *(const LAS f32x4*)(FF + k * 8 + 4), k0 = *(const LAS f32x4*)(KK + k * 8), k1 = *(const LAS f32x4*)(KK + k * 8 + 4),
                    q0 = *(const LAS f32x4*)(QQ + k * 8), q1 = *(const LAS f32x4*)(QQ + k * 8 + 4);
        f32x4 s = S4[0];
#pragma unroll
        for (int t = 0; t < 8; ++t) { const float ft = t < 4 ? f0[t & 3] : f1[t & 3], kt = t < 4 ? k0[t & 3] : k1[t & 3], qt = t < 4 ? q0[t & 3] : q1[t & 3];
            const f32x4 vt = *(const LAS f32x4*)(VV + t * 128 + 4 * v4);
            s = s * ft + vt * kt; O[t] += s * qt; }
        if (!dry) *(f32x4*)(S1 + kk * 128) = s;
#pragma unroll
        for (int r = 0; r < 7; ++r) S4[r] = S4[r + 1];
    }
#pragma unroll
    for (int t = 0; t < 8; ++t) *(LAS f32x4*)(ORED + (kq * 8 + t) * 128 + 4 * v4) = O[t];
    lds_barrier();
    {   const int t = tid >> 6, vp = tid & 63; float o0 = 0.f, o1 = 0.f;
#pragma unroll
        for (int g = 0; g < 16; ++g) { o0 += ORED[(g * 8 + t) * 128 + 2 * vp]; o1 += ORED[(g * 8 + t) * 128 + 2 * vp + 1]; }
        if (!dry) *(unsigned*)(Vb + (row0 + t) * 1024 + h * 128 + 2 * vp) = cvt_pk_bf16(o0, o1);
    }
    lds_barrier();
}

constexpr int HR_QR = 0, HR_LFT = 8704, HR_VR = 18944, HR_SIZE = 27648;
constexpr int HO_QM = 0, HO_KM = 8704, HO_KMT = 17408, HO_VT = 27648, HO_E1 = 37888, HO_E2 = 38400, HO_SIZE = 38912;
constexpr int HC_RAW = 0, HC_OPS = 2 * HR_SIZE;
static_assert(HC_OPS + 2 * HO_SIZE <= 147456 - 64, "hgrn chain LDS map");
__device__ __forceinline__ void hgrn_chain(const Params& p, LAS unsigned char* lds, int b, int h, bool dry = false) {
    const int tid = threadIdx.x, lane = tid & 63, w = __builtin_amdgcn_readfirstlane(tid >> 6), fr = lane & 15, fq = lane >> 4;
    unsigned char* ws = p.ws;
    const bf16_t* Qb = (const bf16_t*)(ws + WS_GRP0 + G_Q * GRP_BYTES); const bf16_t* LFb = (const bf16_t*)(ws + WS_GRP0 + G_LF * GRP_BYTES);
    bf16_t* Vb = (bf16_t*)(ws + WS_GRP0 + G_V * GRP_BYTES);
    const int gt = tid >> 4, gc = tid & 15;
    const int kk0 = 16 * w + fr;
    const int kperm = 32 * (w >> 1) + 8 * (fr >> 2) + 4 * (w & 1) + (fr & 3);
    bf16x8 Lf0, Lf1;
    {   union { unsigned short s[8]; bf16x8 v; } l0, l1;
#pragma unroll
        for (int j = 0; j < 8; ++j) { l0.s[j] = (8 * fq + j <= fr) ? 0x3f80 : 0; l1.s[j] = (8 * fq + j <= 16 + fr) ? 0x3f80 : 0; }
        Lf0 = l0.v; Lf1 = l1.v; }
    f32x4 S[8];
#pragma unroll
    for (int kt = 0; kt < 8; ++kt) S[kt] = (f32x4){0.f, 0.f, 0.f, 0.f};
    u32x4 ldq, ldf, ldv;
#define HC_ROW0(n) ((n) == 0 ? (size_t)ROW_META : (size_t)b * 2048 + 32 * ((n) - 1))
#define HC_G(n) do { const int n_ = (n); if (gt < (n_ == 0 ? 16 : 32)) { const size_t off_ = (HC_ROW0(n_) + gt) * 1024 + h * 128 + 8 * gc; \
        ldq = *(const u32x4*)(Qb + off_); ldf = *(const u32x4*)(LFb + off_); ldv = *(const u32x4*)(Vb + off_); } \
        else { ldq = (u32x4){0u, 0u, 0u, 0u}; ldf = ldq; ldv = ldq; } } while (0)
#define HC_W(n) do { LAS unsigned char* raw_ = lds + HC_RAW + ((n) & 1) * HR_SIZE; \
        *(LAS u32x4*)(raw_ + HR_QR + gt * 272 + 16 * gc) = ldq; *(LAS u32x4*)(raw_ + HR_VR + gt * 272 + 16 * gc) = ldv; \
        LAS bf16_t* lft_ = (LAS bf16_t*)(raw_ + HR_LFT) + (8 * gc) * 40 + gt; \
        lft_[0] = (bf16_t)(ldf.x & 0xffffu); lft_[40] = (bf16_t)(ldf.x >> 16); lft_[80] = (bf16_t)(ldf.y & 0xffffu); lft_[120] = (bf16_t)(ldf.y >> 16); \
        lft_[160] = (bf16_t)(ldf.z & 0xffffu); lft_[200] = (bf16_t)(ldf.z >> 16); lft_[240] = (bf16_t)(ldf.w & 0xffffu); lft_[280] = (bf16_t)(ldf.w >> 16); } while (0)
#define HC_P(n) do { LAS unsigned char* raw_ = lds + HC_RAW + ((n) & 1) * HR_SIZE; LAS unsigned char* ops_ = lds + HC_OPS + ((n) & 1) * HO_SIZE; \
        const LAS bf16_t* LFT_ = (const LAS bf16_t*)(raw_ + HR_LFT); const LAS bf16_t* QR_ = (const LAS bf16_t*)(raw_ + HR_QR); const LAS bf16_t* VR_ = (const LAS bf16_t*)(raw_ + HR_VR); \
        const bf16x8 lfT_ = *(const LAS bf16x8*)(LFT_ + kk0 * 40 + 8 * fq); \
        const f32x4 z_ = (f32x4){0.f, 0.f, 0.f, 0.f}; \
        f32x4 bc_[2]; bc_[0] = mfma16(Lf0, lfT_, z_); bc_[1] = mfma16(Lf1, lfT_, z_); \
        const float b15_ = __shfl(bc_[0][3], 48 + fr), b31_ = __shfl(bc_[1][3], 48 + fr); \
        _Pragma("unroll") for (int tt_ = 0; tt_ < 2; ++tt_) { \
            const u32x2 lfw_ = *(const LAS u32x2*)(LFT_ + kk0 * 40 + 16 * tt_ + 4 * fq); \
            float lfv_[4]; lfv_[0] = bflo(lfw_.x); lfv_[1] = bfhi(lfw_.x); lfv_[2] = bflo(lfw_.y); lfv_[3] = bfhi(lfw_.y); \
            float kmv_[4], vvv_[4]; \
            _Pragma("unroll") for (int i_ = 0; i_ < 4; ++i_) { const int t_ = 16 * tt_ + 4 * fq + i_; \
                const float q_ = bf2f(QR_[t_ * 136 + kk0]); vvv_[i_] = bf2f(VR_[t_ * 136 + kk0]); const float bt_ = bc_[tt_][i_]; \
                const float qm_ = q_ * __expf(bt_ - b15_); kmv_[i_] = (1.0f - __expf(lfv_[i_])) * __expf(b15_ - bt_); \
                const bf16_t kmb_ = f2bf(kmv_[i_]); \
                ((LAS bf16_t*)(ops_ + HO_QM))[t_ * 136 + kperm] = f2bf(qm_); ((LAS bf16_t*)(ops_ + HO_KM))[t_ * 136 + kperm] = kmb_; } \
            u32x2 kw_, vw_; kw_.x = cvt_pk_bf16(kmv_[0], kmv_[1]); kw_.y = cvt_pk_bf16(kmv_[2], kmv_[3]); vw_.x = cvt_pk_bf16(vvv_[0], vvv_[1]); vw_.y = cvt_pk_bf16(vvv_[2], vvv_[3]); \
            *(LAS u32x2*)((LAS bf16_t*)(ops_ + HO_KMT) + kk0 * 40 + 16 * tt_ + 4 * fq) = kw_; *(LAS u32x2*)((LAS bf16_t*)(ops_ + HO_VT) + kk0 * 40 + 16 * tt_ + 4 * fq) = vw_; } \
        if (fq == 0) { ((LAS float*)(ops_ + HO_E1))[kk0] = __expf(b15_); ((LAS float*)(ops_ + HO_E2))[kk0] = __expf(b31_ - b15_); } } while (0)
    HC_G(0); HC_W(0); HC_G(1);
    lds_barrier();
    HC_P(0); HC_W(1); HC_G(2);
    lds_barrier();
    for (int c = 0; c < 65; ++c) {
        const size_t row0 = HC_ROW0(c);
        LAS unsigned char* ops = lds + HC_OPS + (c & 1) * HO_SIZE;
        const LAS bf16_t* QM = (const LAS bf16_t*)(ops + HO_QM); const LAS bf16_t* KM = (const LAS bf16_t*)(ops + HO_KM); const LAS bf16_t* KMT = (const LAS bf16_t*)(ops + HO_KMT);
        const LAS bf16_t* VT = (const LAS bf16_t*)(ops + HO_VT); const LAS float* E1 = (const LAS float*)(ops + HO_E1); const LAS float* E2 = (const LAS float*)(ops + HO_E2);
#pragma unroll
        for (int kt = 0; kt < 8; ++kt) { const f32x4 e = *(const LAS f32x4*)(E1 + 16 * kt + 4 * fq); S[kt] = S[kt] * e; }
        bf16x8 qf[2][4], kf[2][4];
#pragma unroll
        for (int mt = 0; mt < 2; ++mt)
#pragma unroll
            for (int ks = 0; ks < 4; ++ks) { qf[mt][ks] = *(const LAS bf16x8*)(QM + (16 * mt + fr) * 136 + 32 * ks + 8 * fq); kf[mt][ks] = *(const LAS bf16x8*)(KM + (16 * mt + fr) * 136 + 32 * ks + 8 * fq); }
        f32x4 a00 = (f32x4){0.f, 0.f, 0.f, 0.f}, a10 = a00, a11 = a00;
#pragma unroll
        for (int ks = 0; ks < 4; ++ks) { a00 = mfma16(kf[0][ks], qf[0][ks], a00); a10 = mfma16(kf[0][ks], qf[1][ks], a10); a11 = mfma16(kf[1][ks], qf[1][ks], a11); }
#pragma unroll
        for (int i = 0; i < 4; ++i) { if (4 * fq + i > fr) { a00[i] = 0.f; a11[i] = 0.f; } }
        bf16x8 aop0, aop1;
        {   union { u32x4 u; bf16x8 v; } c0, c1;
            c0.u.x = cvt_pk_bf16(a00[0], a00[1]); c0.u.y = cvt_pk_bf16(a00[2], a00[3]); c0.u.z = 0u; c0.u.w = 0u;
            c1.u.x = cvt_pk_bf16(a10[0], a10[1]); c1.u.y = cvt_pk_bf16(a10[2], a10[3]); c1.u.z = cvt_pk_bf16(a11[0], a11[1]); c1.u.w = cvt_pk_bf16(a11[2], a11[3]);
            aop0 = c0.v; aop1 = c1.v; }
        f32x4 o0 = (f32x4){0.f, 0.f, 0.f, 0.f}, o1 = o0;
#pragma unroll
        for (int ks = 0; ks < 4; ++ks) { union { u32x4 u; bf16x8 v; } sf;
            sf.u.x = cvt_pk_bf16(S[2 * ks][0], S[2 * ks][1]); sf.u.y = cvt_pk_bf16(S[2 * ks][2], S[2 * ks][3]); sf.u.z = cvt_pk_bf16(S[2 * ks + 1][0], S[2 * ks + 1][1]); sf.u.w = cvt_pk_bf16(S[2 * ks + 1][2], S[2 * ks + 1][3]);
            o0 = mfma16(sf.v, qf[0][ks], o0); o1 = mfma16(sf.v, qf[1][ks], o1); }
        {   union { u32x4 u; bf16x8 v; } vs;
            const u32x2 lo = *(const LAS u32x2*)(VT + (16 * w + fr) * 40 + 4 * fq), hi = *(const LAS u32x2*)(VT + (16 * w + fr) * 40 + 16 + 4 * fq);
            vs.u.x = lo.x; vs.u.y = lo.y; vs.u.z = hi.x; vs.u.w = hi.y;
            o0 = mfma16(vs.v, aop0, o0); o1 = mfma16(vs.v, aop1, o1); }
        if (c > 0 && !dry) {
            u32x2 y0, y1; y0.x = cvt_pk_bf16(o0[0], o0[1]); y0.y = cvt_pk_bf16(o0[2], o0[3]); y1.x = cvt_pk_bf16(o1[0], o1[1]); y1.y = cvt_pk_bf16(o1[2], o1[3]);
            *(u32x2*)(Vb + (row0 + fr) * 1024 + h * 128 + 16 * w + 4 * fq) = y0; *(u32x2*)(Vb + (row0 + 16 + fr) * 1024 + h * 128 + 16 * w + 4 * fq) = y1; }
        {   const bf16x8 vn = *(const LAS bf16x8*)(VT + (16 * w + fr) * 40 + 8 * fq);
#pragma unroll
            for (int kt = 0; kt < 8; ++kt) { const bf16x8 kmt = *(const LAS bf16x8*)(KMT + (16 * kt + fr) * 40 + 8 * fq); S[kt] = mfma16(kmt, vn, S[kt]);
                const f32x4 e = *(const LAS f32x4*)(E2 + 16 * kt + 4 * fq); S[kt] = S[kt] * e; } }
        if (c + 1 < 65) HC_P(c + 1);
        if (c + 2 < 65) HC_W(c + 2);
        if (c + 3 < 65) HC_G(c + 3);
        lds_barrier();
    }
#undef HC_ROW0
#undef HC_G
#undef HC_W
#undef HC_P
    float* SP = p.out + OFF_SP + ((size_t)(b * 8 + h) * 128) * 128;
#pragma unroll
    for (int kt = 0; kt < 8; ++kt)
#pragma unroll
        for (int i = 0; i < 4; ++i) if (!dry) SP[(size_t)(16 * kt + 4 * fq + i) * 128 + 16 * w + fr] = S[kt][i];
}

__device__ __forceinline__ void p2c_finish(const Params& p, bool dry = false) {
    const int tid = threadIdx.x, lane = tid & 63, wave = tid >> 6;
    const int gw = blockIdx.x * NWAVES + wave, NGW = gridDim.x * NWAVES;
    unsigned char* ws = p.ws;
    const bf16_t* Vb = (const bf16_t*)(ws + WS_GRP0 + G_V * GRP_BYTES); bf16_t* OG = (bf16_t*)(ws + WS_GRP0 + G_OG * GRP_BYTES);
    const bf16_t* U = (const bf16_t*)(ws + WS_GRP0 + G_U * GRP_BYTES);
    float gn[16];
#pragma unroll
    for (int q = 0; q < 4; ++q) { const f32x4 v = *(const f32x4*)(p.gnorm + 16 * lane + 4 * q); gn[4 * q] = v.x; gn[4 * q + 1] = v.y; gn[4 * q + 2] = v.z; gn[4 * q + 3] = v.w; }
    for (int m = gw; m < M_MAIN; m += NGW) {
        const u32x4* op = (const u32x4*)(Vb + (size_t)m * 1024 + 16 * lane); u32x4* gp = (u32x4*)(OG + (size_t)m * 1024 + 16 * lane);
        const u32x4 oa = op[0], ob = op[1], ga = gp[0], gb = gp[1];
        float o[16], g[16];
        o[0] = bflo(oa.x); o[1] = bfhi(oa.x); o[2] = bflo(oa.y); o[3] = bfhi(oa.y); o[4] = bflo(oa.z); o[5] = bfhi(oa.z); o[6] = bflo(oa.w); o[7] = bfhi(oa.w);
        o[8] = bflo(ob.x); o[9] = bfhi(ob.x); o[10] = bflo(ob.y); o[11] = bfhi(ob.y); o[12] = bflo(ob.z); o[13] = bfhi(ob.z); o[14] = bflo(ob.w); o[15] = bfhi(ob.w);
        g[0] = bflo(ga.x); g[1] = bfhi(ga.x); g[2] = bflo(ga.y); g[3] = bfhi(ga.y); g[4] = bflo(ga.z); g[5] = bfhi(ga.z); g[6] = bflo(ga.w); g[7] = bfhi(ga.w);
        g[8] = bflo(gb.x); g[9] = bfhi(gb.x); g[10] = bflo(gb.y); g[11] = bfhi(gb.y); g[12] = bflo(gb.z); g[13] = bfhi(gb.z); g[14] = bflo(gb.w); g[15] = bfhi(gb.w);
        float ss = 0.f;
#pragma unroll
        for (int e = 0; e < 16; ++e) ss += o[e] * o[e];
        ss += __shfl_xor(ss, 1); ss += __shfl_xor(ss, 2); ss += __shfl_xor(ss, 4);
        const float rstd = 1.0f / sqrtf(ss * (1.0f / 128.0f) + EPS);
        float y[16];
#pragma unroll
        for (int e = 0; e < 16; ++e) y[e] = o[e] * rstd * gn[e] * g[e];
        u32x4 ya, yb;
        ya.x = cvt_pk_bf16(y[0], y[1]); ya.y = cvt_pk_bf16(y[2], y[3]); ya.z = cvt_pk_bf16(y[4], y[5]); ya.w = cvt_pk_bf16(y[6], y[7]);
        yb.x = cvt_pk_bf16(y[8], y[9]); yb.y = cvt_pk_bf16(y[10], y[11]); yb.z = cvt_pk_bf16(y[12], y[13]); yb.w = cvt_pk_bf16(y[14], y[15]);
        if (!dry) { gp[0] = ya; gp[1] = yb; }
    }
    const int gt = blockIdx.x * NTHREADS + tid, NGT = gridDim.x * NTHREADS;
    for (int e = gt; e < (NB + DBATCH) * 3 * 1024; e += NGT) {
        const int c = e & 1023, rk = e >> 10, sq = rk / 3, kk = rk % 3;
        if (sq < NB) p.out[OFF_CONVP + (size_t)(sq * 3 + kk) * 1024 + c] = bf2f(U[((size_t)sq * 2048 + 2045 + kk) * 1024 + c]);
        else { const int db = sq - NB; p.out[OFF_CONVS + (size_t)(db * 3 + kk) * 1024 + c] = bf2f(U[((size_t)ROW_SAMPLE + db * 8 + 5 + kk) * 1024 + c]); }
    }
}

__device__ __forceinline__ void p4b_rows(const Params& p) {
    const int tid = threadIdx.x, lane = tid & 63, wave = tid >> 6;
    const int gw = blockIdx.x * NWAVES + wave, NGW = gridDim.x * NWAVES;
    const float* MO = (const float*)(p.ws + WS_GRP0 + G_LF * GRP_BYTES);
    bf16_t* HN = (bf16_t*)(p.ws + WS_GRP0 + G_U * GRP_BYTES);
    const f32x4* g1 = (const f32x4*)(p.gains + 1024) + lane; const f32x4* g2 = (const f32x4*)(p.gains + 2048) + lane;
    for (int m = gw; m < M_MAIN; m += NGW) {
        const float* xrow = m < ROW_SAMPLE ? p.x_prompt + (size_t)m * D : p.x_sample + (size_t)(m - ROW_SAMPLE) * D;
        const f32x4* mr = (const f32x4*)(MO + (size_t)m * D) + lane; const f32x4* xr = (const f32x4*)xrow + lane;
        f32x4 v[4], x[4]; float s = 0.f;
#pragma unroll
        for (int j = 0; j < 4; ++j) { v[j] = mr[64 * j]; x[j] = xr[64 * j]; s += (v[j].x * v[j].x + v[j].y * v[j].y) + (v[j].z * v[j].z + v[j].w * v[j].w); }
        const float rstd = 1.0f / sqrtf(wave_sum(s) * (1.f / D) + EPS);
        float s2 = 0.f;
        f32x4* orow = (f32x4*)(p.out + OFF_Y + (size_t)m * D) + lane;
#pragma unroll
        for (int j = 0; j < 4; ++j) { const f32x4 gg = g1[64 * j]; x[j] = x[j] + v[j] * rstd * gg; orow[64 * j] = x[j]; s2 += (x[j].x * x[j].x + x[j].y * x[j].y) + (x[j].z * x[j].z + x[j].w * x[j].w); }
        const float rstd2 = 1.0f / sqrtf(wave_sum(s2) * (1.f / D) + EPS);
        u32x2* o8 = (u32x2*)(HN + (size_t)m * D) + lane;
#pragma unroll
        for (int j = 0; j < 4; ++j) { const f32x4 gg = g2[64 * j]; u32x2 wv; wv.x = cvt_pk_bf16(x[j].x * rstd2 * gg.x, x[j].y * rstd2 * gg.y); wv.y = cvt_pk_bf16(x[j].z * rstd2 * gg.z, x[j].w * rstd2 * gg.w); o8[64 * j] = wv; }
    }
}
__device__ __forceinline__ void p7_rows(const Params& p, bool dry = false) {
    const int tid = threadIdx.x, lane = tid & 63, wave = tid >> 6;
    const int gw = blockIdx.x * NWAVES + wave, NGW = gridDim.x * NWAVES;
    const float* FFB = (const float*)(p.ws + WS_GRP0 + G_U * GRP_BYTES);
    const f32x4* g3 = (const f32x4*)(p.gains + 3072) + lane;
    for (int m = gw; m < M_MAIN; m += NGW) {
        const f32x4* fr_ = (const f32x4*)(FFB + (size_t)m * D) + lane;
        f32x4* orow = (f32x4*)(p.out + OFF_Y + (size_t)m * D) + lane;
        f32x4 v[4], x[4]; float s = 0.f;
#pragma unroll
        for (int j = 0; j < 4; ++j) { v[j] = fr_[64 * j]; x[j] = orow[64 * j]; s += (v[j].x * v[j].x + v[j].y * v[j].y) + (v[j].z * v[j].z + v[j].w * v[j].w); }
        const float rstd = 1.0f / sqrtf(wave_sum(s) * (1.f / D) + EPS);
#pragma unroll
        for (int j = 0; j < 4; ++j) { const f32x4 gg = g3[64 * j]; f32x4 r = x[j] + v[j] * rstd * gg;
#ifdef SANITIZE
#pragma unroll
            for (int e = 0; e < 4; ++e) if (!(fabsf(r[e]) < 1e30f)) r[e] = 1000.0f;
#endif
            if (!dry) orow[64 * j] = r; }
    }
}

__global__ void __launch_bounds__(NTHREADS, 2) fwd(Params p) {
    extern __shared__ __attribute__((aligned(16))) unsigned char lds_raw[];
    LAS unsigned char* lds = (LAS unsigned char*)lds_raw;
    unsigned char* ws = p.ws;
    const int G = gridDim.x, bid = blockIdx.x;
#ifndef PHMASK
#define PHMASK 0xFFF
#endif
#define IN(k) (((PHMASK >> (k)) & 1) && p.ph_lo <= (k) && (k) < p.ph_hi)
#ifndef REPEAT_MASK
#define REPEAT_MASK 0
#endif
#ifndef PROBE_PHASE
#define PROBE_PHASE -1
#endif
#ifndef REP3_CHAIN
#define REP3_CHAIN 1
#endif
#ifndef REP3_RG
#define REP3_RG 1
#endif
#ifndef CG_SEAMS
#define CG_SEAMS 0x000
#endif
#define SEAM(k) do { if (p.use_bar && IN(k) && IN((k) + 1)) { if (((CG_SEAMS >> (k)) & 1) || p.use_bar == 2) cg::this_grid().sync(); else xcd_barrier(bar); } } while (0)
    XcdBarrier bar; bar.bar = (unsigned*)(ws + WS_CTL) + 4096; bar.x = 0; bar.st = nullptr;
    if (p.use_bar) {
        volatile LAS unsigned* st = (volatile LAS unsigned*)(lds + LDS_BYTES - 64);
        if (threadIdx.x < 16) st[threadIdx.x] = 0u;
        __syncthreads();
        bar = xcd_barrier_post((unsigned*)(ws + WS_CTL) + 4096, st);
    }
    bf16_t* GRP[6];
#pragma unroll
    for (int g = 0; g < 6; ++g) GRP[g] = (bf16_t*)(ws + WS_GRP0 + (size_t)g * GRP_BYTES);

    if (IN(0)) p0_prologue(p, lds);
    SEAM(0);
    if (IN(1)) {
        pg8::Gemm g{(const bf16_t*)((unsigned char*)p.out + OFF_SS * 4), (const bf16_t*)(ws + WS_WIN), M_PAD, DIN, D};
        pg8::StaticOrder S; S.init(M_PAD, DIN, G, bid);
        pg8::EpiProj E{ws, (unsigned char*)p.out, p.hgrn_lb};
        pg8::gemm_phase<pg8::EpiProj, pg8::StaticOrder, true, true>(lds, g, S, E);
    }
    SEAM(1);
    if (IN(2)) {
#if PROBE_PHASE == 2
        {   const bool dry = p.pad != 0;
            if (bid < 64) { if (REP3_CHAIN) hgrn_chain(p, lds, bid >> 3, bid & 7, dry); }
            else if (REP3_RG) rg_work(p, lds, bid - 64, G - 64, dry);
            __syncthreads();
        }
#endif
        if (bid < 64) hgrn_chain(p, lds, bid >> 3, bid & 7, false);
        else rg_work(p, lds, bid - 64, G - 64, false);
    }
    SEAM(2);
#if PROBE_PHASE == 3
    if (IN(3)) p2c_finish(p, p.pad != 0);
#endif
    if (IN(3)) p2c_finish(p, false);
    SEAM(3);
    if (IN(4)) {
        pg8::Gemm g{GRP[G_GA], (const bf16_t*)(ws + WS_WA), M_MAIN, D, D};
        pg8::StaticOrder S; S.init(M_MAIN, D, G, bid);
        pg8::EpiGate<0> E{(const bf16_t*)p.out, nullptr, GRP[G_U]};
        pg8::gemm_phase<pg8::EpiGate<0>, pg8::StaticOrder, true, true>(lds, g, S, E);
    }
    SEAM(4);
    if (IN(5)) {
        pg8::Gemm g{GRP[G_OG], (const bf16_t*)(ws + WS_WB), M_MAIN, D, D};
        pg8::StaticOrder S; S.init(M_MAIN, D, G, bid);
        pg8::EpiGate<1> E{(const bf16_t*)((unsigned char*)p.out + GATE_BYTES), GRP[G_U], GRP[G_Q]};
        pg8::gemm_phase<pg8::EpiGate<1>, pg8::StaticOrder, true, true>(lds, g, S, E);
    }
    SEAM(5);
    if (IN(6)) {
        pg8::Gemm g{GRP[G_Q], (const bf16_t*)(ws + WS_WOUT), M_MAIN, D, D};
        pg8::StaticOrder S; S.init(M_MAIN, D, G, bid);
        pg8::EpiF32 E{(float*)GRP[G_LF]};
        pg8::gemm_phase<pg8::EpiF32, pg8::StaticOrder, true, true>(lds, g, S, E);
    }
    SEAM(6);
    if (IN(7)) p4b_rows(p);
    SEAM(7);
    if (IN(8)) {
        pg8::Gemm g{GRP[G_U], (const bf16_t*)(ws + WS_WUP), M_MAIN, DFF, D};
        pg8::StaticOrder S; S.init(M_MAIN, DFF, G, bid);
        pg8::EpiRelu2 E{GRP[G_Q]};
        pg8::gemm_phase<pg8::EpiRelu2, pg8::StaticOrder, true, true>(lds, g, S, E);
    }
    SEAM(8);
    if (IN(9)) {
        pg8::Gemm g{GRP[G_Q], (const bf16_t*)(ws + WS_WDN), M_MAIN, D, DFF};
        pg8::StaticOrder S; S.init(M_MAIN, D, G, bid);
        pg8::EpiF32 E{(float*)GRP[G_U]};
        pg8::gemm_phase<pg8::EpiF32, pg8::StaticOrder, true, true>(lds, g, S, E);
    }
    SEAM(9);
#if PROBE_PHASE == 10
    if (IN(10)) p7_rows(p, p.pad != 0);
#endif
    if (IN(10)) p7_rows(p, false);
#undef IN
#undef SEAM
}

#ifndef N_LAUNCH_MODE
#define N_LAUNCH_MODE 1
#endif
extern "C" void kernel_launch(void* const* d_in, const int* in_sizes, int n_in, void* d_out, int out_size, void* d_ws, size_t ws_size, hipStream_t stream) {
    static int grid = 0;
    if (grid == 0) {
        if (n_in != 22 || (size_t)out_size != OUT_FLOATS || ws_size < WS_END) { fprintf(stderr, "kernel_launch: unexpected sizes (n_in %d, out %d, ws %zu); nothing launched\n", n_in, out_size, ws_size); grid = -1; return; }
        int dev = 0, cus = 0, per_cu = 0;
        if (hipGetDevice(&dev) != hipSuccess || hipDeviceGetAttribute(&cus, hipDeviceAttributeMultiprocessorCount, dev) != hipSuccess) { grid = -1; return; }
        if (hipFuncSetAttribute((const void*)fwd, hipFuncAttributeMaxDynamicSharedMemorySize, LDS_BYTES) != hipSuccess) { fprintf(stderr, "kernel_launch: hipFuncSetAttribute failed\n"); grid = -1; return; }
        if (hipOccupancyMaxActiveBlocksPerMultiprocessor(&per_cu, (const void*)fwd, NTHREADS, LDS_BYTES) != hipSuccess || per_cu < 1) { fprintf(stderr, "kernel_launch: occupancy query failed (%d)\n", per_cu); (void)hipGetLastError(); grid = -1; return; }
        grid = cus;
        if (grid != 256) fprintf(stderr, "kernel_launch: %d CUs; this kernel is laid out for 256\n", grid);
    }
    if (grid < 0) return;
    (void)hipMemsetAsync((char*)d_ws + WS_CTL, 0, CTL_ZERO_BYTES, stream);
    Params p{};
    const float** pp = (const float**)&p;
    for (int i = 0; i < 22; ++i) pp[i] = (const float*)d_in[i];
    p.out = (float*)d_out; p.ws = (unsigned char*)d_ws;
#if PROBE_PHASE >= 0
    p.pad = 1;
#endif
#if N_LAUNCH_MODE == 1
    p.ph_lo = 0; p.ph_hi = NPHASES; p.use_bar = 1;
    void* args[] = {&p};
    hipError_t e = hipLaunchCooperativeKernel((const void*)fwd, dim3(grid), dim3(NTHREADS), args, LDS_BYTES, stream);
    if (e != hipSuccess) fprintf(stderr, "kernel_launch: cooperative launch failed: %s (grid %d)\n", hipGetErrorString(e), grid);
#else
#ifndef NPH_RUN
#define NPH_RUN NPHASES
#endif
    for (int ph = 0; ph < NPH_RUN; ++ph) {
        p.ph_lo = ph; p.ph_hi = ph + 1; p.use_bar = 0;
        hipLaunchKernelGGL(fwd, dim3(grid), dim3(NTHREADS), LDS_BYTES, stream, p);
    }
#ifdef DUMP_V
    (void)hipMemcpyAsync((char*)d_out, (char*)d_ws + WS_GRP0 + G_V * GRP_BYTES, GATE_BYTES, hipMemcpyDeviceToDevice, stream);
    (void)hipMemcpyAsync((char*)d_out + GATE_BYTES, (char*)d_ws + WS_GRP0 + G_V * GRP_BYTES, GATE_BYTES, hipMemcpyDeviceToDevice, stream);
#endif
#ifdef DUMP_YAB
    (void)hipMemcpyAsync((char*)d_out, (char*)d_ws + WS_GRP0 + G_GA * GRP_BYTES, GATE_BYTES, hipMemcpyDeviceToDevice, stream);
    (void)hipMemcpyAsync((char*)d_out + GATE_BYTES, (char*)d_ws + WS_GRP0 + G_OG * GRP_BYTES, GATE_BYTES, hipMemcpyDeviceToDevice, stream);
#endif
#ifdef DUMP_YA
    (void)hipMemcpyAsync((char*)d_out, (char*)d_ws + WS_GRP0 + G_GA * GRP_BYTES, GATE_BYTES, hipMemcpyDeviceToDevice, stream);
    (void)hipMemcpyAsync((char*)d_out + GATE_BYTES, (char*)d_ws + WS_GRP0 + G_GA * GRP_BYTES, GATE_BYTES, hipMemcpyDeviceToDevice, stream);
#endif
#endif
}
```
